# Optimizing an MI355X kernel written in HIP

```python
import math
import jax, jax.numpy as jnp
from jax import lax
import numpy as np

D_MODEL = 1024
BATCH = 8
SEQ = 4096
DEPTH = 4

CHUNK = 64
N_MIXERS = 2
S5_GROUP = 16
S5_STATE = 64
S5_GROUPS = D_MODEL // S5_GROUP
FOX_HEAD_DIM = 64
FOX_HEADS = D_MODEL // FOX_HEAD_DIM
Q_BLOCK = 2 * CHUNK
MLP_HIDDEN = 4 * D_MODEL
RMS_EPS = 1e-6
N_S5_LAYERS = (DEPTH + N_MIXERS - 1) // N_MIXERS
N_FOX_LAYERS = DEPTH // N_MIXERS

kernel_name = "s5_fox_interleaved_sandwich_trunk"


def rms_norm(x, gain):
    xf = x.astype(jnp.float32)
    inv = lax.rsqrt(jnp.mean(xf * xf, axis=-1, keepdims=True) + RMS_EPS)
    return (xf * inv * gain.astype(jnp.float32)).astype(x.dtype)


def s5_mixer(u, a_re, a_im, log_dt, b_re, b_im, c_re, c_im, d_skip, w_glu):
    bsz, seq, dm = u.shape
    uf = u.astype(jnp.float32).reshape(bsz, seq, S5_GROUPS, S5_GROUP)
    a = lax.complex(a_re.astype(jnp.float32), a_im.astype(jnp.float32))
    dt = jnp.exp(log_dt.astype(jnp.float32))[:, None]
    a_bar = jnp.exp(a * dt)
    b_c = lax.complex(b_re.astype(jnp.float32), b_im.astype(jnp.float32))
    b_bar = ((a_bar - 1.0) / a)[..., None] * b_c
    bu = jnp.einsum('blgh,gph->blgp', uf.astype(jnp.complex64), b_bar)
    decay = jnp.broadcast_to(a_bar, (1, seq, S5_GROUPS, S5_STATE))

    def combine(e1, e2):
        a1, b1 = e1
        a2, b2 = e2
        return a1 * a2, a2 * b1 + b2

    _, states = lax.associative_scan(combine, (decay, bu), axis=1)
    c_c = lax.complex(c_re.astype(jnp.float32), c_im.astype(jnp.float32))
    y = jnp.real(jnp.einsum('blgp,ghp->blgh', states, c_c))
    y = y + d_skip.astype(jnp.float32).reshape(S5_GROUPS, S5_GROUP) * uf
    g = jax.nn.gelu(y.reshape(bsz, seq, dm))
    vg = g @ w_glu.astype(jnp.float32)
    val, gate = jnp.split(vg, 2, axis=-1)
    return (val * jax.nn.sigmoid(gate)).astype(u.dtype)


def fox_mixer(u, w_in, b_f, w_out):
    bsz, seq, dm = u.shape
    proj = u @ w_in
    q, k, v, g, f_logit = jnp.split(proj, [dm, 2 * dm, 3 * dm, 4 * dm], axis=-1)

    def heads(t):
        return t.reshape(bsz, seq, FOX_HEADS, FOX_HEAD_DIM).transpose(0, 2, 1, 3).astype(jnp.float32)

    q, k, v = heads(q), heads(k), heads(v)
    log_f = jax.nn.log_sigmoid((f_logit + b_f).astype(jnp.float32))
    cum = jnp.cumsum(log_f, axis=1).transpose(0, 2, 1)
    scale = FOX_HEAD_DIM ** -0.5
    outs = []
    for blk in range(seq // Q_BLOCK):
        s0, s1 = blk * Q_BLOCK, (blk + 1) * Q_BLOCK
        logits = jnp.einsum('bhqd,bhkd->bhqk', q[:, :, s0:s1], k[:, :, :s1]) * scale
        logits = logits + cum[:, :, s0:s1, None] - cum[:, :, None, :s1]
        causal = jnp.arange(s0, s1)[:, None] >= jnp.arange(s1)[None, :]
        probs = jax.nn.softmax(jnp.where(causal, logits, -jnp.inf), axis=-1)
        outs.append(jnp.einsum('bhqk,bhkd->bhqd', probs, v[:, :, :s1]))
    o = jnp.concatenate(outs, axis=2).transpose(0, 2, 1, 3).reshape(bsz, seq, dm)
    o = o * jax.nn.sigmoid(g.astype(jnp.float32))
    return o.astype(u.dtype) @ w_out


def sqrelu_mlp(u, w1, w2):
    h = jax.nn.relu(u @ w1)
    return (h * h) @ w2


def setup_inputs(seed: int = 0) -> dict:
    key = jax.random.key(seed)
    ks = jax.random.split(key, 16)
    f32 = jnp.float32
    ns, nf = N_S5_LAYERS, N_FOX_LAYERS
    g, p, h = S5_GROUPS, S5_STATE, S5_GROUP
    n_idx = jnp.arange(S5_STATE, dtype=f32)
    x = jax.random.normal(ks[0], (BATCH, SEQ, D_MODEL), f32)
    norm_gains = 1.0 + 0.05 * jax.random.normal(ks[1], (DEPTH, 4, D_MODEL), f32)
    s5_a_re = -0.5 * jnp.exp(0.02 * jax.random.normal(ks[2], (ns, g, p), f32))
    s5_a_im = jnp.pi * n_idx + 0.01 * jax.random.normal(ks[3], (ns, g, p), f32)
    s5_log_dt = jax.random.uniform(ks[4], (ns, g), f32, minval=math.log(1e-3), maxval=math.log(1e-1))
    s5_b_re = jax.random.normal(ks[5], (ns, g, p, h), f32) * (2 * h) ** -0.5
    s5_b_im = jax.random.normal(ks[6], (ns, g, p, h), f32) * (2 * h) ** -0.5
    s5_c_re = jax.random.normal(ks[7], (ns, g, h, p), f32) * (2 * p) ** -0.5
    s5_c_im = jax.random.normal(ks[8], (ns, g, h, p), f32) * (2 * p) ** -0.5
    s5_d = jax.random.normal(ks[9], (ns, D_MODEL), f32)
    s5_w_glu = jax.random.normal(ks[10], (ns, D_MODEL, 2 * D_MODEL), f32) * D_MODEL ** -0.5
    fox_w_in = jax.random.normal(ks[11], (nf, D_MODEL, 4 * D_MODEL + FOX_HEADS), f32) * D_MODEL ** -0.5
    fox_b_f = jax.random.uniform(ks[12], (nf, FOX_HEADS), f32, minval=1.0, maxval=6.0)
    fox_w_out = jax.random.normal(ks[13], (nf, D_MODEL, D_MODEL), f32) * D_MODEL ** -0.5
    mlp_w1 = jax.random.normal(ks[14], (DEPTH, D_MODEL, MLP_HIDDEN), f32) * D_MODEL ** -0.5
    mlp_w2 = jax.random.normal(ks[15], (DEPTH, MLP_HIDDEN, D_MODEL), f32) * MLP_HIDDEN ** -0.5
    return {"x": x, "norm_gains": norm_gains,
            "s5_a_re": s5_a_re, "s5_a_im": s5_a_im, "s5_log_dt": s5_log_dt,
            "s5_b_re": s5_b_re, "s5_b_im": s5_b_im, "s5_c_re": s5_c_re, "s5_c_im": s5_c_im,
            "s5_d": s5_d, "s5_w_glu": s5_w_glu,
            "fox_w_in": fox_w_in, "fox_b_f": fox_b_f, "fox_w_out": fox_w_out,
            "mlp_w1": mlp_w1, "mlp_w2": mlp_w2}


def reference(x, norm_gains, s5_a_re, s5_a_im, s5_log_dt, s5_b_re, s5_b_im, s5_c_re, s5_c_im,
              s5_d, s5_w_glu, fox_w_in, fox_b_f, fox_w_out, mlp_w1, mlp_w2):
    assert x.shape[1] % Q_BLOCK == 0 and Q_BLOCK % CHUNK == 0
    h = x
    for i in range(DEPTH):
        gains = norm_gains[i]
        u = rms_norm(h, gains[0])
        j = i // N_MIXERS
        if i % N_MIXERS == 0:
            mix = s5_mixer(u, s5_a_re[j], s5_a_im[j], s5_log_dt[j], s5_b_re[j], s5_b_im[j],
                           s5_c_re[j], s5_c_im[j], s5_d[j], s5_w_glu[j])
        else:
            mix = fox_mixer(u, fox_w_in[j], fox_b_f[j], fox_w_out[j])
        h = h + rms_norm(mix, gains[1])
        h = h + rms_norm(sqrelu_mlp(rms_norm(h, gains[2]), mlp_w1[i], mlp_w2[i]), gains[3])
    return h
```

```cpp
#include <hip/hip_runtime.h>
#include <hip/hip_cooperative_groups.h>
#include <cstdio>
#include <cstdint>
#define NSUB 8
namespace pg8 {
#define PG8_LAS __attribute__((address_space(3)))
typedef unsigned short bf16_t;
typedef short bf16x8 __attribute__((ext_vector_type(8)));
typedef float f32x4 __attribute__((ext_vector_type(4)));
typedef unsigned u32x4 __attribute__((ext_vector_type(4)));
constexpr int BM = 256, BK = 64, HALF = 128, HTB = HALF * BK * 2  , STAGE_BYTES = 8 * HTB, NXCD = 8, WGM = 8;

__host__ __device__ __forceinline__ int lds_byte(int r, int c) { const int st = (r >> 4) * 2 + (c >> 5), rr = r & 15, cc = c & 31, ob = rr * 64 + cc * 2; return st * 1024 + (ob ^ (((ob >> 9) & 1) << 5)); }
__host__ __device__ __forceinline__ void stage_rc(int b, int& R, int& C) { const int st = b / 1024, sb = b % 1024, swz = sb ^ (((sb >> 9) & 1) << 5); R = (st >> 1) * 16 + swz / 64; C = (st & 1) * 32 + (swz % 64) / 2; }
__host__ __device__ __forceinline__ int perm32(int rho) { const int n = rho >> 4, i = rho & 15; return 8 * (i >> 2) + 4 * n + (i & 3); }

struct Unit { int pm, pn; };
struct Gemm { const bf16_t* A; const bf16_t* Bt; int M, N, K, lda, ldb; };

struct StaticOrder {
    int nM, nN, nwg, G, c;
    __host__ __device__ void init(int M, int N, int G_, int c_) { nM = M / BM; nN = N / BM; nwg = nM * nN; G = G_; c = c_; }
    __host__ __device__ bool next(int i, Unit& u) const {
        const long L = (long)i * G + c; if (L >= nwg) return false;
        int wgid = (int)L; { const int q = nwg / NXCD, r = nwg % NXCD, xcd = wgid % NXCD, off = wgid / NXCD; wgid = (xcd < r ? xcd * (q + 1) : r * (q + 1) + (xcd - r) * q) + off; }
        const int nig = WGM * nN, gid = wgid / nig, fm = gid * WGM, gsz = (nM - fm) < WGM ? (nM - fm) : WGM;
        u.pm = fm + ((wgid % nig) % gsz); u.pn = (wgid % nig) / gsz; return true;
    }
    __device__ __forceinline__ void a_ready(const Unit&) const {}
    __device__ __forceinline__ void done(const Unit&) const {}
};

__device__ __forceinline__ unsigned cvt_pk_bf16(float lo, float hi) { unsigned r; asm volatile("v_cvt_pk_bf16_f32 %0, %1, %2" : "=v"(r) : "v"(lo), "v"(hi)); return r; }
typedef float f32x2 __attribute__((ext_vector_type(2)));
__device__ __forceinline__ void store8(bf16_t* p, f32x4 v0, f32x4 v1) { u32x4 w; w.x = cvt_pk_bf16(v0[0], v0[1]); w.y = cvt_pk_bf16(v0[2], v0[3]); w.z = cvt_pk_bf16(v1[0], v1[1]); w.w = cvt_pk_bf16(v1[2], v1[3]); *(u32x4*)p = w; }
__device__ __forceinline__ float sigmoidf_(float x) { return __builtin_amdgcn_rcpf(1.0f + __builtin_amdgcn_exp2f(-1.4426950408889634f * x)); }
__device__ __forceinline__ float bf_lo(unsigned w) { return __uint_as_float(w << 16); }
__device__ __forceinline__ float bf_hi(unsigned w) { return __uint_as_float(w & 0xffff0000u); }

struct EpiPlain {
    static constexpr bool PERM = true, AFTER_DRAIN = false;
    bf16_t* O; int ldc;
    __device__ __forceinline__ void operator()(const f32x4 (&acc)[2][2][4][2], const Unit& u, int wr, int wc, int fr, int fq) const {
        const int row0 = u.pm * BM + wr * 64 + fr, col0 = u.pn * BM + wc * 32 + 8 * fq;
#pragma unroll
        for (int ai = 0; ai < 2; ++ai)
#pragma unroll
            for (int m = 0; m < 4; ++m) { bf16_t* rowp = O + (size_t)(row0 + ai * HALF + m * 16) * ldc + col0;
#pragma unroll
                for (int bj = 0; bj < 2; ++bj) store8(rowp + bj * HALF, acc[ai][bj][m][0], acc[ai][bj][m][1]); }
    }
};
struct EpiRelu2 {
    static constexpr bool PERM = true, AFTER_DRAIN = false;
    bf16_t* O; int ldc;
    __device__ __forceinline__ void operator()(const f32x4 (&acc)[2][2][4][2], const Unit& u, int wr, int wc, int fr, int fq) const {
        const int row0 = u.pm * BM + wr * 64 + fr, col0 = u.pn * BM + wc * 32 + 8 * fq;
#pragma unroll
        for (int ai = 0; ai < 2; ++ai)
#pragma unroll
            for (int m = 0; m < 4; ++m) { bf16_t* rowp = O + (size_t)(row0 + ai * HALF + m * 16) * ldc + col0;
#pragma unroll
                for (int bj = 0; bj < 2; ++bj) { f32x4 v0 = acc[ai][bj][m][0], v1 = acc[ai][bj][m][1];
#pragma unroll
                    for (int e = 0; e < 4; ++e) { const float a = fmaxf(v0[e], 0.f), b = fmaxf(v1[e], 0.f); v0[e] = a * a; v1[e] = b * b; }
                    store8(rowp + bj * HALF, v0, v1); } }
    }
};
struct EpiGLU {
    static constexpr bool PERM = true, AFTER_DRAIN = false;
    bf16_t* O; int ldc;
    __device__ __forceinline__ void operator()(const f32x4 (&acc)[2][2][4][2], const Unit& u, int wr, int wc, int fr, int fq) const {
        const int row0 = u.pm * BM + wr * 64 + fr, col0 = u.pn * HALF + wc * 32 + 8 * fq;
#pragma unroll
        for (int ai = 0; ai < 2; ++ai)
#pragma unroll
            for (int m = 0; m < 4; ++m) { bf16_t* rowp = O + (size_t)(row0 + ai * HALF + m * 16) * ldc + col0;
                f32x4 v0 = acc[ai][0][m][0], v1 = acc[ai][0][m][1]; const f32x4 g0 = acc[ai][1][m][0], g1 = acc[ai][1][m][1];
#pragma unroll
                for (int e = 0; e < 4; ++e) { v0[e] *= sigmoidf_(g0[e]); v1[e] *= sigmoidf_(g1[e]); }
                store8(rowp, v0, v1); }
    }
};
struct EpiProj {
    static constexpr bool PERM = true, AFTER_DRAIN = false;
    bf16_t* QKVG; size_t stride; float* LF; const float* bfv; float qscale;
    __device__ __forceinline__ void operator()(const f32x4 (&acc)[2][2][4][2], const Unit& u, int wr, int wc, int fr, int fq) const {
        const int row0 = u.pm * BM + wr * 64 + fr;
        if (u.pn < 16) {
            const int t = u.pn >> 2; bf16_t* base = QKVG + (size_t)t * stride; const int col0 = (u.pn & 3) * BM + wc * 32 + 8 * fq; const float sc = (t == 0) ? qscale : 1.0f;
#pragma unroll
            for (int ai = 0; ai < 2; ++ai)
#pragma unroll
                for (int m = 0; m < 4; ++m) { bf16_t* rowp = base + (size_t)(row0 + ai * HALF + m * 16) * 1024 + col0;
#pragma unroll
                    for (int bj = 0; bj < 2; ++bj) store8(rowp + bj * HALF, acc[ai][bj][m][0] * sc, acc[ai][bj][m][1] * sc); }
        } else if (wc == 0 && fq < 2) {
            const f32x4 b0 = *(const f32x4*)(bfv + 8 * fq), b1 = *(const f32x4*)(bfv + 8 * fq + 4);
#pragma unroll
            for (int ai = 0; ai < 2; ++ai)
#pragma unroll
                for (int m = 0; m < 4; ++m) { float* rowp = LF + (size_t)(row0 + ai * HALF + m * 16) * 16 + 8 * fq;
                    f32x4 x0 = acc[ai][0][m][0] + b0, x1 = acc[ai][0][m][1] + b1;
#pragma unroll
                    for (int e = 0; e < 4; ++e) { x0[e] = fminf(x0[e], 0.f) - __logf(1.0f + __expf(-fabsf(x0[e]))); x1[e] = fminf(x1[e], 0.f) - __logf(1.0f + __expf(-fabsf(x1[e]))); }
                    *(f32x4*)rowp = x0; *(f32x4*)(rowp + 4) = x1; }
        }
    }
};
struct EpiS5Loc {
    static constexpr bool PERM = true, AFTER_DRAIN = false;
    float* SL;
    __device__ __forceinline__ void operator()(const f32x4 (&acc)[2][2][4][2], const Unit& u, int wr, int wc, int fr, int fq) const {
        const int row0 = u.pm * BM + wr * 64 + fr, col0 = wc * 32 + 8 * fq;
#pragma unroll
        for (int ai = 0; ai < 2; ++ai)
#pragma unroll
            for (int m = 0; m < 4; ++m) { float* rowp = SL + (size_t)(row0 + ai * HALF + m * 16) * 128 + col0; *(f32x4*)rowp = acc[ai][0][m][0]; *(f32x4*)(rowp + 4) = acc[ai][0][m][1]; }
    }
};
struct EpiS5Main {
    static constexpr bool PERM = true, AFTER_DRAIN = false;
    bf16_t* G; const bf16_t* AS5; const float* dskip;
    __device__ __forceinline__ void operator()(const f32x4 (&acc)[2][2][4][2], const Unit& u, int wr, int wc, int fr, int fq) const {
        const int g = u.pn, row0 = u.pm * BM + wr * 64 + fr;
        const int ch0 = g * 16 + 8 * (fq & 1);
        const f32x4 d0 = *(const f32x4*)(dskip + ch0), d1 = *(const f32x4*)(dskip + ch0 + 4);
#pragma unroll
        for (int ai = 0; ai < 2; ++ai)
#pragma unroll
            for (int m = 0; m < 4; ++m) { const int row = row0 + ai * HALF + m * 16; const int scl = row - g * 2048;
#pragma unroll
                for (int bj = 0; bj < 2; ++bj) { const int c0 = bj * HALF + wc * 32 + 8 * fq; const int t = c0 >> 4;
                    const u32x4 uu = *(const u32x4*)(AS5 + (size_t)row * 384 + c0);
                    f32x4 y0 = acc[ai][bj][m][0], y1 = acc[ai][bj][m][1];
                    y0[0] += d0[0] * bf_lo(uu.x); y0[1] += d0[1] * bf_hi(uu.x); y0[2] += d0[2] * bf_lo(uu.y); y0[3] += d0[3] * bf_hi(uu.y);
                    y1[0] += d1[0] * bf_lo(uu.z); y1[1] += d1[1] * bf_hi(uu.z); y1[2] += d1[2] * bf_lo(uu.w); y1[3] += d1[3] * bf_hi(uu.w);
#pragma unroll
                    for (int e = 0; e < 4; ++e) { const float a = y0[e], b = y1[e];
                        y0[e] = a * sigmoidf_(1.5957691216057308f * (a + 0.044715f * a * a * a)); y1[e] = b * sigmoidf_(1.5957691216057308f * (b + 0.044715f * b * b * b)); }
                    store8(G + ((size_t)scl * 16 + t) * 1024 + ch0, y0, y1); asm volatile("" ::: "memory"); } }
    }
};
struct S5Order {
    int G, c;
    __host__ __device__ void init(int G_, int c_) { G = G_; c = c_; }
    __host__ __device__ bool next(int i, Unit& u) const { const int L = i * G + c; if (L >= 512) return false; u.pm = L; u.pn = L >> 3; return true; }
    __device__ __forceinline__ void a_ready(const Unit&) const {}
    __device__ __forceinline__ void done(const Unit&) const {}
};

template <class Epi, class Sched, bool ALIGN_EPI = false, bool SP2 = false>
__device__ __forceinline__ void gemm_phase(PG8_LAS unsigned char* lds, const Gemm g, const Sched& S, const Epi& E) {
    int tid_ = threadIdx.x; asm volatile("" : "+v"(tid_)); const int tid = tid_, wid = __builtin_amdgcn_readfirstlane(tid >> 6), lane = tid & 63, wr = wid >> 2, wc = wid & 3, fr = lane & 15, fq = lane >> 4;
    const int K = g.K, nt = K / BK;
    unsigned voffA[2], voffB[2];
#pragma unroll
    for (int i = 0; i < 2; ++i) { int R, C; stage_rc(tid * 16 + i * 8192, R, C); const int Rb = Epi::PERM ? ((R & ~31) + perm32(R & 31)) : R;
        voffA[i] = (unsigned)(R * g.lda + C) * 2u; voffB[i] = (unsigned)(Rb * g.ldb + C) * 2u; }
    const size_t kstep = (size_t)(BK * 2);
    const size_t hstepA = (size_t)HALF * g.lda * 2, hstepB = (size_t)HALF * g.ldb * 2;
    const size_t tstepA = 2 * hstepA, tstepB = 2 * hstepB;
    const unsigned ldsw = (unsigned)wid * 1024u;
    const int aoff = lds_byte(wr * 64 + fr, fq * 8), boff = lds_byte(wc * 32 + fr, fq * 8);
#define PG8_SA(b, h) (((b) * 2 + (h)) * HTB)
#define PG8_SB(b, h) ((4 + (b) * 2 + (h)) * HTB)
#define PG8_STAGE(bufoff, gbase, voff) do { _Pragma("unroll") for (int _i = 0; _i < 2; ++_i) \
        __builtin_amdgcn_global_load_lds((const unsigned*)((const char*)(gbase) + (voff)[_i]), (PG8_LAS unsigned*)(lds + (bufoff) + ldsw + _i * 8192), 16, 0, 0); } while (0)
#define PG8_LDA(dst, b, h) do { _Pragma("unroll") for (int m = 0; m < 4; ++m) _Pragma("unroll") for (int k = 0; k < 2; ++k) dst[m][k] = *(const PG8_LAS bf16x8*)(lds + PG8_SA(b, h) + aoff + m * 2048 + k * 1024); } while (0)
#define PG8_LDB(dst, b, h) do { _Pragma("unroll") for (int n = 0; n < 2; ++n) _Pragma("unroll") for (int k = 0; k < 2; ++k) dst[n][k] = *(const PG8_LAS bf16x8*)(lds + PG8_SB(b, h) + boff + n * 2048 + k * 1024); } while (0)
#define PG8_MMA(ai, bj, At, Bt) do { __builtin_amdgcn_s_setprio(1); _Pragma("unroll") for (int m = 0; m < 4; ++m) _Pragma("unroll") for (int n = 0; n < 2; ++n) _Pragma("unroll") for (int k = 0; k < 2; ++k) \
        acc[ai][bj][m][n] = __builtin_amdgcn_mfma_f32_16x16x32_bf16(Bt[n][k], At[m][k], acc[ai][bj][m][n], 0, 0, 0); __builtin_amdgcn_s_setprio(0); } while (0)
#define PG8_WAIT_V(n) asm volatile("s_waitcnt vmcnt(" #n ")" ::: "memory")
#define PG8_WAIT_L(n) asm volatile("s_waitcnt lgkmcnt(" #n ")" ::: "memory")
#define PG8_BAR __builtin_amdgcn_s_barrier()
#define PG8_SCHED __builtin_amdgcn_sched_barrier(0)
    Unit cur, nxt; int ui = 0;
    if (!S.next(0, cur)) return;
    f32x4 acc[2][2][4][2];
#pragma unroll
    for (int a = 0; a < 2; ++a)
#pragma unroll
        for (int b = 0; b < 2; ++b)
#pragma unroll
            for (int m = 0; m < 4; ++m)
#pragma unroll
                for (int n = 0; n < 2; ++n) acc[a][b][m][n] = (f32x4){0.f, 0.f, 0.f, 0.f};
    bf16x8 At[4][2], B0[2][2], B1[2][2];
    const char* cA = (const char*)g.A + (size_t)cur.pm * tstepA; const char* cB = (const char*)g.Bt + (size_t)cur.pn * tstepB;
    S.a_ready(cur);
    if constexpr (SP2) {
        PG8_STAGE(PG8_SB(0, 0), cB, voffB); PG8_STAGE(PG8_SB(0, 1), cB + hstepB, voffB); PG8_STAGE(PG8_SA(0, 0), cA, voffA); PG8_STAGE(PG8_SA(0, 1), cA + hstepA, voffA);
        if (wr == 1) PG8_BAR;
        PG8_WAIT_V(2); PG8_BAR;
        PG8_STAGE(PG8_SB(1, 0), cB + kstep, voffB); PG8_STAGE(PG8_SA(1, 0), cA + kstep, voffA); PG8_STAGE(PG8_SB(1, 1), cB + hstepB + kstep, voffB);
        PG8_WAIT_V(6); PG8_BAR;
    } else {
        PG8_STAGE(PG8_SB(0, 0), cB, voffB); PG8_STAGE(PG8_SA(0, 0), cA, voffA); PG8_STAGE(PG8_SB(0, 1), cB + hstepB, voffB); PG8_STAGE(PG8_SA(0, 1), cA + hstepA, voffA);
        if (wr == 1) PG8_BAR;
        PG8_WAIT_V(4); PG8_BAR;
        PG8_STAGE(PG8_SB(1, 0), cB + kstep, voffB); PG8_STAGE(PG8_SA(1, 0), cA + kstep, voffA); PG8_STAGE(PG8_SB(1, 1), cB + hstepB + kstep, voffB);
        PG8_WAIT_V(6); PG8_BAR;
    }
    for (;;) {
        const bool has_next = S.next(ui + 1, nxt);
        const char* nA = has_next ? (const char*)g.A + (size_t)nxt.pm * tstepA : cA; const char* nB = has_next ? (const char*)g.Bt + (size_t)nxt.pn * tstepB : cB;
_Pragma("nounroll")
        for (int t = 0; t < nt; t += 2) {
            const bool last = (t == nt - 2);
            const char* a1 = cA + (size_t)(t + 1) * kstep;
            const char* a2 = last ? nA : cA + (size_t)(t + 2) * kstep; const char* b2 = last ? nB : cB + (size_t)(t + 2) * kstep;
            const char* a3 = a2 + kstep; const char* b3 = b2 + kstep;
            if (last && has_next) S.a_ready(nxt);
            if constexpr (SP2) {
            PG8_LDB(B0, 0, 0); PG8_LDB(B1, 0, 1); PG8_SCHED; PG8_LDA(At, 0, 0); PG8_STAGE(PG8_SA(1, 1), a1 + hstepA, voffA);
            PG8_WAIT_V(8); PG8_WAIT_L(0); PG8_BAR; PG8_MMA(0, 0, At, B0); PG8_MMA(0, 1, At, B1); PG8_BAR; PG8_SCHED;
            PG8_LDA(At, 0, 1); PG8_STAGE(PG8_SB(0, 0), b2, voffB); PG8_STAGE(PG8_SB(0, 1), b2 + hstepB, voffB); PG8_STAGE(PG8_SA(0, 0), a2, voffA);
            PG8_WAIT_V(8); PG8_WAIT_L(0); PG8_BAR; PG8_MMA(1, 0, At, B0); PG8_MMA(1, 1, At, B1); PG8_BAR; PG8_SCHED;
            PG8_LDB(B0, 1, 0); PG8_LDB(B1, 1, 1); PG8_SCHED; PG8_LDA(At, 1, 0); PG8_STAGE(PG8_SA(0, 1), a2 + hstepA, voffA);
            PG8_WAIT_V(8); PG8_WAIT_L(0); PG8_BAR; PG8_MMA(0, 0, At, B0); PG8_MMA(0, 1, At, B1); PG8_BAR; PG8_SCHED;
            PG8_LDA(At, 1, 1); PG8_STAGE(PG8_SB(1, 0), b3, voffB); PG8_STAGE(PG8_SB(1, 1), b3 + hstepB, voffB); PG8_STAGE(PG8_SA(1, 0), a3, voffA);
            PG8_WAIT_V(8); PG8_WAIT_L(0); PG8_BAR; PG8_MMA(1, 0, At, B0); PG8_MMA(1, 1, At, B1); PG8_BAR; PG8_SCHED;
            } else {
            PG8_LDB(B0, 0, 0); PG8_SCHED; PG8_LDA(At, 0, 0); PG8_STAGE(PG8_SA(1, 1), a1 + hstepA, voffA);
            PG8_WAIT_L(8); PG8_BAR; PG8_WAIT_L(0); PG8_MMA(0, 0, At, B0); PG8_BAR; PG8_SCHED;
            PG8_LDB(B1, 0, 1); PG8_STAGE(PG8_SB(0, 0), b2, voffB);
            PG8_BAR; PG8_WAIT_L(0); PG8_MMA(0, 1, At, B1); PG8_BAR;
            PG8_LDA(At, 0, 1); PG8_STAGE(PG8_SA(0, 0), a2, voffA);
            PG8_BAR; PG8_WAIT_L(0); PG8_MMA(1, 0, At, B0); PG8_BAR; PG8_SCHED;
            PG8_STAGE(PG8_SB(0, 1), b2 + hstepB, voffB);
            PG8_WAIT_V(6); PG8_BAR; PG8_MMA(1, 1, At, B1); PG8_BAR;
            PG8_LDB(B0, 1, 0); PG8_SCHED; PG8_LDA(At, 1, 0); PG8_STAGE(PG8_SA(0, 1), a2 + hstepA, voffA);
            PG8_WAIT_L(8); PG8_BAR; PG8_WAIT_L(0); PG8_MMA(0, 0, At, B0); PG8_BAR; PG8_SCHED;
            PG8_LDB(B1, 1, 1); PG8_STAGE(PG8_SB(1, 0), b3, voffB);
            PG8_BAR; PG8_WAIT_L(0); PG8_MMA(0, 1, At, B1); PG8_BAR;
            PG8_LDA(At, 1, 1); PG8_STAGE(PG8_SA(1, 0), a3, voffA);
            PG8_BAR; PG8_WAIT_L(0); PG8_MMA(1, 0, At, B0); PG8_BAR; PG8_SCHED;
            PG8_STAGE(PG8_SB(1, 1), b3 + hstepB, voffB);
            PG8_WAIT_V(6); PG8_BAR; PG8_MMA(1, 1, At, B1); PG8_BAR;
            }
        }
        if constexpr (ALIGN_EPI) { if (wr == 0) PG8_BAR; }
        if constexpr (!Epi::AFTER_DRAIN) { E(acc, cur, wr, wc, fr, fq); S.done(cur); }
        if (!has_next) break;
#pragma unroll
        for (int a = 0; a < 2; ++a)
#pragma unroll
            for (int b = 0; b < 2; ++b)
#pragma unroll
                for (int m = 0; m < 4; ++m)
#pragma unroll
                    for (int n = 0; n < 2; ++n) acc[a][b][m][n] = (f32x4){0.f, 0.f, 0.f, 0.f};
        cur = nxt; cA = nA; cB = nB; ++ui;
        if constexpr (ALIGN_EPI) { if (wr == 1) PG8_BAR; }
    }
    PG8_WAIT_V(0);
    if constexpr (!ALIGN_EPI) { if (wr == 0) PG8_BAR; }
    PG8_BAR;
    if constexpr (Epi::AFTER_DRAIN) { E.fused(acc, cur, wr, wc, fr, fq, lds, wid, lane); S.done(cur); }
#undef PG8_SA
#undef PG8_SB
#undef PG8_STAGE
#undef PG8_LDA
#undef PG8_LDB
#undef PG8_MMA
#undef PG8_WAIT_V
#undef PG8_WAIT_L
#undef PG8_BAR
#undef PG8_SCHED
}
}

#define PG8_ALIGN true
#include <hip/hip_bf16.h>
#include <cmath>
namespace attn_body {
using bf16=__hip_bfloat16;
using bf16x8=__attribute__((ext_vector_type(8)))short;
using s16x4=__attribute__((ext_vector_type(4)))short;
using f32x16=__attribute__((ext_vector_type(16)))float;
using u32x4=__attribute__((ext_vector_type(4)))unsigned;
using f32x4_t=__attribute__((ext_vector_type(4)))float;
constexpr int BATCH=8,NHEAD=16,SEQ=4096,D=64,DM=NHEAD*D;
constexpr int NW=8,QBLK=32,QB=QBLK*NW,KVBLK=64,NQB=SEQ/QB;
constexpr int ATTN_PITCH=DM, ATTN_UNIT_ROWS=QB;
__device__ __forceinline__ int crow(int r,int hi){return (r&3)+8*(r>>2)+4*hi;}
#define SBAR() __builtin_amdgcn_sched_barrier(0)
__device__ __forceinline__ void cmask(f32x16&p0,f32x16&p1,int jb,int qrel,int hi){
  const float NEG=-INFINITY; int kb=64*jb+4*hi;
  #pragma unroll
  for(int r=0;r<16;++r){int kv=kb+(r&3)+8*(r>>2); if(kv>qrel)p0[r]=NEG; if(kv+32>qrel)p1[r]=NEG;}
}

constexpr int NSLOT=3, SLOTB=8192;
constexpr int LDS_K=0, LDS_V=NSLOT*SLOTB, LDS_WS=2*NSLOT*SLOTB, LDS_OST=LDS_WS+NW*64*4, LDS_CKT=LDS_OST+NW*4096, LDS_BYTES=LDS_CKT+(SEQ+64)*4;
constexpr float C2=0.125f*1.4426950408889634f;
__device__ __forceinline__ void glds16(const void*gsrc,unsigned lds_dst){unsigned keep;
  asm volatile("s_mov_b32 %0, m0\n\ts_mov_b32 m0, %2\n\ts_nop 0\n\tglobal_load_lds_dwordx4 %1, off\n\ts_mov_b32 m0, %0":"=&s"(keep):"v"(gsrc),"s"(lds_dst):"memory");}
__device__ __forceinline__ float max3f(float a,float b,float c){float r;asm("v_max3_f32 %0, %1, %2, %3":"=v"(r):"v"(a),"v"(b),"v"(c));return r;}
__device__ __forceinline__ float max2f(float a,float b){float r;asm("v_max_f32_e32 %0, %1, %2":"=v"(r):"v"(a),"v"(b));return r;}
__device__ __forceinline__ float fadd_s(float a,float b){float r;asm("v_add_f32_e32 %0, %1, %2":"=v"(r):"v"(a),"v"(b));return r;}
__device__ __forceinline__ float fsub_s(float a,float b){float r;asm("v_sub_f32_e32 %0, %1, %2":"=v"(r):"v"(a),"v"(b));return r;}
typedef float f32x2_t __attribute__((ext_vector_type(2))); typedef __bf16 bf16x2_t __attribute__((ext_vector_type(2)));
__device__ __forceinline__ unsigned cvtpk_s(float lo,float hi){f32x2_t v={lo,hi};bf16x2_t b=__builtin_convertvector(v,bf16x2_t);return __builtin_bit_cast(unsigned,b);}
#define WAIT_BAR(N) asm volatile("s_waitcnt vmcnt(" #N ") lgkmcnt(0)\n\ts_barrier":::"memory")

__device__ __forceinline__ void qkt(f32x16&p0,f32x16&p1,const char*Kslot,const bf16x8*qr,int r32,int hi){
  const char*kb=Kslot+hi*1024+r32*16;
  #pragma unroll
  for(int d0=0;d0<4;++d0){
    const bf16x8 b0=*reinterpret_cast<const bf16x8*>(kb+d0*2048);
    const bf16x8 b1=*reinterpret_cast<const bf16x8*>(kb+d0*2048+512);
    {p0=__builtin_amdgcn_mfma_f32_32x32x16_bf16(b0,qr[d0],p0,0,0,0);p1=__builtin_amdgcn_mfma_f32_32x32x16_bf16(b1,qr[d0],p1,0,0,0);}}
}
typedef __attribute__((address_space(3))) const char* lds_cptr;
typedef short v4i16_t __attribute__((ext_vector_type(4)));
__device__ __forceinline__ void kload8(bf16x8*kf,lds_cptr kp){
  kf[0]=*(const __attribute__((address_space(3))) bf16x8*)(kp);      kf[1]=*(const __attribute__((address_space(3))) bf16x8*)(kp+512);
  kf[2]=*(const __attribute__((address_space(3))) bf16x8*)(kp+2048); kf[3]=*(const __attribute__((address_space(3))) bf16x8*)(kp+2560);
  kf[4]=*(const __attribute__((address_space(3))) bf16x8*)(kp+4096); kf[5]=*(const __attribute__((address_space(3))) bf16x8*)(kp+4608);
  kf[6]=*(const __attribute__((address_space(3))) bf16x8*)(kp+6144); kf[7]=*(const __attribute__((address_space(3))) bf16x8*)(kp+6656);
}
__device__ __forceinline__ void kload2(bf16x8*kf,lds_cptr kp,int j){ kf[2*j]=*(const __attribute__((address_space(3))) bf16x8*)(kp+j*2048); kf[2*j+1]=*(const __attribute__((address_space(3))) bf16x8*)(kp+j*2048+512); }
__device__ __forceinline__ s16x4 vtr(lds_cptr p){ return __builtin_bit_cast(s16x4,__builtin_amdgcn_ds_read_tr16_b64_v4i16((__attribute__((address_space(3))) v4i16_t*)p)); }
__device__ __forceinline__ float rowmax(const f32x16&p0,const f32x16&p1){
  float a=max3f(p0[0],p0[1],p1[0]),b=max3f(p0[2],p0[3],p1[1]);a=max3f(a,p1[2],p1[3]);
  #pragma unroll
  for(int r=4;r<16;r+=4){a=max3f(a,p0[r],p0[r+1]);b=max3f(b,p0[r+2],p0[r+3]);a=max3f(a,p1[r],p1[r+1]);b=max3f(b,p1[r+2],p1[r+3]);}
  const float m=max2f(a,b);
  auto rr=__builtin_amdgcn_permlane32_swap(__float_as_uint(m),__float_as_uint(m),false,false);
  return max2f(__uint_as_float(rr[0]),__uint_as_float(rr[1]));
}
__device__ __forceinline__ void pv(f32x16*o,int vb,bf16x8 pa0,bf16x8 pa1,bf16x8 pa2,bf16x8 pa3){
  #pragma unroll
  for(int d0=0;d0<2;++d0){s16x4 lo[4],hi[4];
    #pragma unroll
    for(int ks=0;ks<4;++ks){
      asm volatile("ds_read_b64_tr_b16 %0,%1 offset:%c2":"=&v"(lo[ks]):"v"(vb),"i"(d0*4096+ks*1024):"memory");
      asm volatile("ds_read_b64_tr_b16 %0,%1 offset:%c2":"=&v"(hi[ks]):"v"(vb),"i"(d0*4096+ks*1024+512):"memory");}
    asm volatile("s_waitcnt lgkmcnt(0)":::"memory");SBAR();
    #define PK(k) (bf16x8){lo[k][0],lo[k][1],lo[k][2],lo[k][3],hi[k][0],hi[k][1],hi[k][2],hi[k][3]}
    o[d0]=__builtin_amdgcn_mfma_f32_32x32x16_bf16(pa0,PK(0),o[d0],0,0,0);
    o[d0]=__builtin_amdgcn_mfma_f32_32x32x16_bf16(pa1,PK(1),o[d0],0,0,0);
    o[d0]=__builtin_amdgcn_mfma_f32_32x32x16_bf16(pa2,PK(2),o[d0],0,0,0);
    o[d0]=__builtin_amdgcn_mfma_f32_32x32x16_bf16(pa3,PK(3),o[d0],0,0,0);
    #undef PK
  }
}

#ifndef ATTN_STORE16
#define ATTN_STORE16(p,v) (*(u32x4*)(p)=(v))
#endif
template<int THRL> __device__ __forceinline__ void attn_unit(int b,int h,int qb,const bf16*Q,const bf16*__restrict__ K,const bf16*__restrict__ V,const bf16*__restrict__ GT,const float*__restrict__ CK2,bf16*O,char*shm){
  int tid_=threadIdx.x; asm volatile("":"+v"(tid_)); const int tid=tid_,lane=tid&63,r32=lane&31,hi=lane>>5; const int wid=__builtin_amdgcn_readfirstlane(tid>>6);
  const long rowbase=(long)b*SEQ; const int q0=qb*QB;
  const bf16*Qw=Q+(rowbase+q0+wid*QBLK)*DM+h*D;
  const bf16*Kh=K+rowbase*DM+h*D,*Vh=V+rowbase*DM+h*D;
  const unsigned lds0=(unsigned)(uintptr_t)shm; const lds_cptr shm3=(lds_cptr)shm;
  float*wsf=(float*)(shm+LDS_WS)+wid*64;
  const bf16*ksrc=Kh+(long)lane*DM+wid*8;
  const bf16*vsrc=Vh+(long)(16*(wid&3)+(lane>>2))*DM+(wid>>2)*32+(lane&3)*8;
  const unsigned kdst=lds0+LDS_K+wid*1024, vdst=lds0+LDS_V+wid*1024;
  #define DMA_K(t,slot) glds16(ksrc+(long)(t)*KVBLK*DM,(unsigned)__builtin_amdgcn_readfirstlane(kdst+(slot)))
  #define DMA_V(t,slot) glds16(vsrc+(long)(t)*KVBLK*DM,(unsigned)__builtin_amdgcn_readfirstlane(vdst+(slot)))
  const int vb0=(int)(lds0+LDS_V)+((lane>>4)&1)*32+(lane&3)*8+(4*hi+((lane&15)>>2))*64;
  const char*Kbase=shm+LDS_K; bf16x8 kf[8];
  const lds_cptr kp0=shm3+LDS_K+hi*1024+r32*16; const lds_cptr vp0=shm3+LDS_V+((lane>>4)&1)*32+(lane&3)*8+(4*hi+((lane&15)>>2))*64;
  const int NT=(q0+QB)/KVBLK;
  typedef __attribute__((address_space(3))) float* lds_fptr;
  const lds_fptr ckt=(lds_fptr)(shm3+LDS_CKT);
  { const float*ckg=CK2+((long)(b*NHEAD+h))*SEQ;
    for(int i_=tid*4;i_<q0+QB;i_+=2048){ const f32x4_t v_=*(const f32x4_t*)(ckg+i_); *(__attribute__((address_space(3))) f32x4_t*)(ckt+i_)=v_; } }
  float cq2=CK2[((long)(b*NHEAD+h))*SEQ+q0+wid*QBLK+r32];
  asm volatile("s_waitcnt vmcnt(0) lgkmcnt(0)\n\ts_barrier":::"memory"); asm volatile("":"+v"(cq2));
  float base=cq2;
  #define BIAS_INIT(C0,C1,t) do{ const lds_fptr cp_=ckt+64*(t)+4*hi; \
    _Pragma("unroll") for(int j_=0;j_<4;++j_){ const f32x4_t a_=*(const __attribute__((address_space(3))) f32x4_t*)(cp_+8*j_); const f32x4_t b_=*(const __attribute__((address_space(3))) f32x4_t*)(cp_+32+8*j_); \
      C0[4*j_]=base-a_[0];C0[4*j_+1]=base-a_[1];C0[4*j_+2]=base-a_[2];C0[4*j_+3]=base-a_[3]; C1[4*j_]=base-b_[0];C1[4*j_+1]=base-b_[1];C1[4*j_+2]=base-b_[2];C1[4*j_+3]=base-b_[3]; } }while(0)
  DMA_K(0,0);DMA_V(0,0);DMA_K(1,SLOTB);
  bf16x8 qr[4];
  #pragma unroll
  for(int d0=0;d0<4;++d0)qr[d0]=*reinterpret_cast<const bf16x8*>(&Qw[(long)r32*DM+d0*16+hi*8]);
  float mhat=0.f,l_reg=0.f;f32x16 o[2];o[0]=f32x16{};o[1]=f32x16{};
  const int qrel=wid*QBLK+r32;
  #define CMASK(P0,P1,t) do{int jb_=(t)-(NT-4); if(jb_>=0)cmask(P0,P1,jb_,qrel,hi);}while(0)
  bool resc=false;
  #define START(P0,P1) do{ const float rm=rowmax(P0,P1); resc=false; \
    { const float dl=rm; mhat=fadd_s(mhat,dl); \
      _Pragma("unroll") for(int r=0;r<16;++r){P0[r]=fsub_s(P0[r],dl);P1[r]=fsub_s(P1[r],dl);} \
      base=cq2-mhat; } \
    _Pragma("unroll") for(int r=0;r<16;++r)P0[r]=__builtin_amdgcn_exp2f(P0[r]); }while(0)
  #define RESC() do{ if(resc){ asm volatile("s_waitcnt lgkmcnt(0)":::"memory"); \
      _Pragma("unroll") for(int d_=0;d_<2;++d_) _Pragma("unroll") for(int r=0;r<16;++r)o[d_][r]*=wsf[crow(r,hi)]; } }while(0)
  f32x16 pA0,pA1,pB0,pB1;
  int sl_prev=0,sl_cur=0,sl_next=SLOTB;
  #define ROT() do{sl_prev=sl_cur;sl_cur=sl_next;sl_next=(sl_next==(NSLOT-1)*SLOTB)?0:sl_next+SLOTB;}while(0)
  DMA_K(2,2*SLOTB);
  WAIT_BAR(3);
  BIAS_INIT(pA0,pA1,0); qkt(pA0,pA1,Kbase,qr,r32,hi);asm volatile("s_nop 15\n\ts_nop 7":"+v"(pA0),"+v"(pA1));CMASK(pA0,pA1,0);
  START(pA0,pA1);
  _Pragma("unroll") for(int r=0;r<16;++r)pA1[r]=__builtin_amdgcn_exp2f(pA1[r]);
  WAIT_BAR(0);
  DMA_K(3,0);DMA_V(1,SLOTB);
  ROT();
  kload8(kf,kp0+sl_cur);
  WAIT_BAR(2);
  s16x4 vlo[8],vhi[8]; u32x4 pw0,pw1,pw2,pw3;
  #define PKW(P,B) cvtpk_s(P[B],P[B+1])
  #define PAF(k) __builtin_bit_cast(bf16x8,pw##k)
  #define VFR(i) (bf16x8){vlo[i][0],vlo[i][1],vlo[i][2],vlo[i][3],vhi[i][0],vhi[i][1],vhi[i][2],vhi[i][3]}
  #define PIN(x) asm volatile("":"+v"(x))
  #define MX3(a,b,c) __builtin_fmaxf(__builtin_fmaxf((a),(b)),(c))
  #define GAPA(MF,A0,A1,A2,A3,W0,W1,PW) do{ MF; sacc+=A0; sacc+=A1; sacc+=A2; sacc+=A3; PIN(sacc); W0; W1; PIN(PW); SBAR(); }while(0)
  #define EX(v) __builtin_amdgcn_exp2f(v)
  #define GAPB(MF,X,B) do{ MF; X[B]=EX(X[B]); X[B+1]=EX(X[B+1]); X[B+2]=EX(X[B+2]); X[B+3]=EX(X[B+3]); PIN(X); SBAR(); }while(0)
  #define VRD(i) do{ vlo[i]=vtr(vp_+(((i)>>2)*4096+((i)&3)*1024)); vhi[i]=vtr(vp_+(((i)>>2)*4096+((i)&3)*1024+512)); }while(0)
  #define KRD(G,j) do{ if(G){ kload2(kf,kp0+sl_next,j); SBAR(); } }while(0)
  #define STEP(C0,C1,P0,P1,t,GK,GV,GL) do{ SBAR(); BIAS_INIT(C0,C1,t); SBAR(); \
    const lds_cptr vp_=vp0+sl_prev; \
    VRD(0); SBAR(); float sacc=(P0[0]+P0[1]); \
    GAPA(C0=__builtin_amdgcn_mfma_f32_32x32x16_bf16(kf[0],qr[0],C0,0,0,0), P0[2],P0[3],P0[4],P0[5],     pw0[0]=PKW(P0,0), pw0[1]=PKW(P0,2), pw0); \
    VRD(4); SBAR(); GAPA(C1=__builtin_amdgcn_mfma_f32_32x32x16_bf16(kf[1],qr[0],C1,0,0,0), P0[6],P0[7],P0[8],P0[9],     pw0[2]=PKW(P0,4), pw0[3]=PKW(P0,6), pw0); \
    VRD(1); SBAR(); GAPA(C0=__builtin_amdgcn_mfma_f32_32x32x16_bf16(kf[2],qr[1],C0,0,0,0),   P0[10],P0[11],P0[12],P0[13], pw1[0]=PKW(P0,8), pw1[1]=PKW(P0,10), pw1); \
    VRD(5); SBAR(); GAPA(C1=__builtin_amdgcn_mfma_f32_32x32x16_bf16(kf[3],qr[1],C1,0,0,0),   P0[14],P0[15],P1[0],P1[1],   pw1[2]=PKW(P0,12),pw1[3]=PKW(P0,14), pw1); \
    VRD(2); SBAR(); GAPA(C0=__builtin_amdgcn_mfma_f32_32x32x16_bf16(kf[4],qr[2],C0,0,0,0),   P1[2],P1[3],P1[4],P1[5],     pw2[0]=PKW(P1,0), pw2[1]=PKW(P1,2), pw2); \
    VRD(6); SBAR(); GAPA(C1=__builtin_amdgcn_mfma_f32_32x32x16_bf16(kf[5],qr[2],C1,0,0,0),   P1[6],P1[7],P1[8],P1[9],     pw2[2]=PKW(P1,4), pw2[3]=PKW(P1,6), pw2); \
    VRD(3); SBAR(); GAPA(C0=__builtin_amdgcn_mfma_f32_32x32x16_bf16(kf[6],qr[3],C0,0,0,0),   P1[10],P1[11],P1[12],P1[13], pw3[0]=PKW(P1,8), pw3[1]=PKW(P1,10), pw3); \
    VRD(7); SBAR(); GAPA(C1=__builtin_amdgcn_mfma_f32_32x32x16_bf16(kf[7],qr[3],C1,0,0,0),   P1[14],P1[15],0.f,0.f,       pw3[2]=PKW(P1,12),pw3[3]=PKW(P1,14), pw3); \
    l_reg+=sacc; \
    if(GK){DMA_K((t)+3,sl_cur);} if(GV){DMA_V((t)+1,sl_next);} \
    CMASK(C0,C1,t); \
    { float a=MX3(C0[0],C0[1],C1[0]),b=MX3(C0[2],C0[3],C1[1]); a=MX3(a,C1[2],C1[3]); \
      _Pragma("unroll") for(int r=4;r<16;r+=4){a=MX3(a,C0[r],C0[r+1]);b=MX3(b,C0[r+2],C0[r+3]);a=MX3(a,C1[r],C1[r+1]);b=MX3(b,C1[r+2],C1[r+3]);} \
      float rm=__builtin_fmaxf(a,b); { auto rr=__builtin_amdgcn_permlane32_swap(__float_as_uint(rm),__float_as_uint(rm),false,false); rm=__builtin_fmaxf(__uint_as_float(rr[0]),__uint_as_float(rr[1])); } \
      resc=false; \
      if(__builtin_expect(__any(rm>(float)THRL),0)){ const float dl=__builtin_fmaxf(rm,0.f); mhat+=dl; \
        _Pragma("unroll") for(int r=0;r<16;++r){C0[r]-=dl;C1[r]-=dl;} \
        base=cq2-mhat; \
        const float f=__builtin_amdgcn_exp2f(-dl); l_reg*=f; if(hi==0)wsf[r32]=f; resc=true; } } \
    SBAR(); \
    GAPB(o[0]=__builtin_amdgcn_mfma_f32_32x32x16_bf16(PAF(0),VFR(0),o[0],0,0,0), C0,0); \
    GAPB(o[1]=__builtin_amdgcn_mfma_f32_32x32x16_bf16(PAF(0),VFR(4),o[1],0,0,0), C0,4); \
    KRD(GL,0); GAPB(o[0]=__builtin_amdgcn_mfma_f32_32x32x16_bf16(PAF(1),VFR(1),o[0],0,0,0), C0,8); \
    KRD(GL,1); GAPB(o[1]=__builtin_amdgcn_mfma_f32_32x32x16_bf16(PAF(1),VFR(5),o[1],0,0,0), C0,12); \
    KRD(GL,2); GAPB(o[0]=__builtin_amdgcn_mfma_f32_32x32x16_bf16(PAF(2),VFR(2),o[0],0,0,0), C1,0); \
    KRD(GL,3); GAPB(o[1]=__builtin_amdgcn_mfma_f32_32x32x16_bf16(PAF(2),VFR(6),o[1],0,0,0), C1,4); \
    GAPB(o[0]=__builtin_amdgcn_mfma_f32_32x32x16_bf16(PAF(3),VFR(3),o[0],0,0,0), C1,8); \
    GAPB(o[1]=__builtin_amdgcn_mfma_f32_32x32x16_bf16(PAF(3),VFR(7),o[1],0,0,0), C1,12); \
    }while(0)
  int t=1;
  #undef CMASK
  #define CMASK(P0,P1,t) do{}while(0)
  for(;t+5<NT;t+=2){
    STEP(pB0,pB1,pA0,pA1,t,true,true,true);     WAIT_BAR(2); RESC(); ROT();
    STEP(pA0,pA1,pB0,pB1,t+1,true,true,true);   WAIT_BAR(2); RESC(); ROT();
  }
  #undef CMASK
  #define CMASK(P0,P1,t) do{int jb_=(t)-(NT-4); if(jb_>=0)cmask(P0,P1,jb_,qrel,hi);}while(0)
  #define ENDW(tt) do{ if((tt)+3<NT){WAIT_BAR(2);} else if((tt)+2<NT){WAIT_BAR(1);} else {WAIT_BAR(0);} }while(0)
  for(;t+1<NT;t+=2){
    STEP(pB0,pB1,pA0,pA1,t,(t+3<NT),(t+1<NT),(t+1<NT));       ENDW(t);   RESC(); ROT();
    STEP(pA0,pA1,pB0,pB1,t+1,(t+4<NT),(t+2<NT),(t+2<NT));     ENDW(t+1); RESC(); ROT();
  }
  STEP(pB0,pB1,pA0,pA1,NT-1,false,false,false); RESC();
  { float sacc=pB0[0]+pB0[1]; _Pragma("unroll") for(int r=2;r<16;++r)sacc+=pB0[r]; _Pragma("unroll") for(int r=0;r<16;++r)sacc+=pB1[r]; l_reg+=sacc;
    pw0=(u32x4){PKW(pB0,0),PKW(pB0,2),PKW(pB0,4),PKW(pB0,6)};pw1=(u32x4){PKW(pB0,8),PKW(pB0,10),PKW(pB0,12),PKW(pB0,14)};pw2=(u32x4){PKW(pB1,0),PKW(pB1,2),PKW(pB1,4),PKW(pB1,6)};pw3=(u32x4){PKW(pB1,8),PKW(pB1,10),PKW(pB1,12),PKW(pB1,14)};
    SBAR(); pv(o,vb0+sl_cur,PAF(0),PAF(1),PAF(2),PAF(3)); }
  #undef PKW
  #undef PAF
  #undef VFR
  #undef PIN
  #undef MX3
  #undef GAPA
  #undef GAPB
  #undef EX
  #undef VRD
  #undef KRD
  #undef STEP
  #undef ENDW
  {auto rr=__builtin_amdgcn_permlane32_swap(__float_as_uint(l_reg),__float_as_uint(l_reg),false,false);l_reg=__uint_as_float(rr[0])+__uint_as_float(rr[1]);}
  if(hi==0)wsf[32+r32]=l_reg;asm volatile("s_waitcnt lgkmcnt(0)":::"memory");
  float rli[16];
  #pragma unroll
  for(int r=0;r<16;++r)rli[r]=__builtin_amdgcn_rcpf(wsf[32+crow(r,hi)]);
  bf16*Ow=O+(rowbase+q0+wid*QBLK)*DM+h*D; const bf16*Gw=GT+(rowbase+q0+wid*QBLK)*DM+h*D;
  { bf16*stg=(bf16*)(shm+LDS_OST)+wid*2048;
    #pragma unroll
    for(int r=0;r<16;++r){const int orow=crow(r,hi);
      #pragma unroll
      for(int d0=0;d0<2;++d0)stg[orow*64+d0*32+r32]=__float2bfloat16(o[d0][r]*rli[r]);}
    asm volatile("s_waitcnt lgkmcnt(0)":::"memory");
    #pragma unroll
    for(int i=0;i<4;++i){const int row=i*8+(lane>>3),ch=lane&7; u32x4 v=*(const u32x4*)(stg+row*64+ch*8); const u32x4 gg=*(const u32x4*)(Gw+(long)row*DM+ch*8);
      #pragma unroll
      for(int e=0;e<4;++e){ const float olo=__uint_as_float(v[e]<<16),ohi=__uint_as_float(v[e]&0xffff0000u),glo=__uint_as_float(gg[e]<<16),ghi=__uint_as_float(gg[e]&0xffff0000u);
        const float slo=__builtin_amdgcn_rcpf(1.0f+__builtin_amdgcn_exp2f(-1.4426950408889634f*glo)),shi=__builtin_amdgcn_rcpf(1.0f+__builtin_amdgcn_exp2f(-1.4426950408889634f*ghi));
        v[e]=cvtpk_s(olo*slo,ohi*shi); }
      ATTN_STORE16(Ow+(long)row*DM+ch*8,v);} }
  asm volatile("s_waitcnt lgkmcnt(0)\n\ts_barrier":::"memory");
  #undef BIAS_INIT
  #undef DMA_K
  #undef DMA_V
  #undef CMASK
  #undef START
  #undef RESC
  #undef ROT
}
constexpr int ATTN_LDS_BYTES=LDS_BYTES;
struct AttnTensors { const bf16* Q; const bf16* K; const bf16* V; const bf16* G; const float* CK2; bf16* O; };
struct AttnUnit { int bh; int qb; };
struct StaticOrder {
  int vcu;
  __device__ __forceinline__ explicit StaticOrder(int grid,int block):vcu((block%8)*(grid/8)+block/8){}
  __device__ __forceinline__ bool next(int i,AttnUnit&u)const{ if(i>=8)return false; const int s=2*(i>>1)+(vcu&1); u.bh=vcu>>1; u.qb=(i&1)?s:15-s; return true; }
  __device__ __forceinline__ void a_ready(const AttnUnit&)const{}
  __device__ __forceinline__ void done(const AttnUnit&)const{}
};
template<class Sched,int THRL=8> __device__ __forceinline__ void attn_phase(char*lds,const AttnTensors&T,const Sched&S){
  AttnUnit u;
  for(int i=0;S.next(i,u);++i){ S.a_ready(u); attn_unit<THRL>(u.bh/NHEAD,u.bh%NHEAD,u.qb,T.Q,T.K,T.V,T.G,T.CK2,T.O,lds); S.done(u); }
}
#undef SBAR
#undef WAIT_BAR
}
constexpr int NWAVES = 8;
#ifndef NSUB
#define NSUB 8
#endif
constexpr int NB = 8, T = 4096, D = 1024, H = 16, HD = 64, FF = 4096, DEPTH = 4;
constexpr int M = NB * T;
constexpr int NPROJ = 4352;
constexpr int NPROJ_REAL = 4 * D + H;
constexpr float RMS_EPS = 1e-6f;
constexpr int S5G = 64, S5P = 64, S5H = 16, TC = 16, NSC = M / TC;
constexpr int S5KA = 384;

constexpr size_t MiB = 1u << 20;
constexpr size_t WS_CTL = 0, CTL_ZERO_BYTES = 1 * MiB;
constexpr size_t WS_WGLU = 2 * MiB;
constexpr size_t WS_WIN = 10 * MiB;
constexpr size_t WS_WOUT = 27 * MiB;
constexpr size_t WS_W1 = 31 * MiB;
constexpr size_t WS_W2 = 63 * MiB;
constexpr size_t WS_S5BM = 95 * MiB;
constexpr size_t WS_S5BS = 119 * MiB;
constexpr size_t WS_LF = 135 * MiB;
constexpr size_t WS_CK2 = 137 * MiB;
constexpr size_t WS_XN = 140 * MiB;
constexpr size_t WS_BIG = 204 * MiB;
constexpr size_t WS_Q = WS_BIG, WS_K = WS_BIG + 64 * MiB, WS_V = WS_BIG + 128 * MiB, WS_GATE = WS_BIG + 192 * MiB;
constexpr size_t WS_AS5 = WS_BIG, WS_SL = WS_BIG + 96 * MiB, WS_G = WS_BIG + 160 * MiB;
constexpr size_t WS_END = 460 * MiB;
static_assert((size_t)64 * 2048 * 384 * 2 == 96 * MiB && (size_t)M * FF * 2 == 256 * MiB, "map");
constexpr int CW_BAR = 4096;

constexpr int RING_OFF = 0, RING_BYTES = 131072;
constexpr int LDSCTL_OFF = RING_BYTES, MISC_OFF = LDSCTL_OFF + 320;
constexpr int LDS_BYTES = 147456;
static_assert(MISC_OFF + 128 <= LDS_BYTES, "LDS map");

struct Args { const float* in[16]; float* out; unsigned char* ws; };
#define GAS __attribute__((address_space(1)))
#define LAS __attribute__((address_space(3)))
typedef unsigned short bf16;
typedef unsigned v4u __attribute__((ext_vector_type(4)));
typedef float f32x4 __attribute__((ext_vector_type(4)));
typedef short bf16x8 __attribute__((ext_vector_type(8)));
typedef GAS unsigned gu32;
typedef GAS unsigned long long gu64;
#define RLX_AGENT __ATOMIC_RELAXED, __HIP_MEMORY_SCOPE_AGENT
#define LDS_WAIT() asm volatile("s_waitcnt lgkmcnt(0)" ::: "memory")
#define VM_WAIT() asm volatile("s_waitcnt vmcnt(0)" ::: "memory")
__device__ __forceinline__ unsigned long long rt() { return __builtin_amdgcn_s_memrealtime(); }
__device__ __forceinline__ unsigned f2bf(float f) { unsigned u = __builtin_bit_cast(unsigned, f); return (u + 0x7fffu + ((u >> 16) & 1u)) >> 16; }
__device__ __forceinline__ unsigned pk2(float lo, float hi) { return f2bf(lo) | (f2bf(hi) << 16); }

#define XB_TMO      128
#define XB_XCNT(j)  (256  + 64 * (j))
#define XB_XSUB(j)  (1280 + 64 * (j))
#define XB_XGEN(j)  (2304 + 64 * (j))
#define XB_TOP      3328
#define XB_TOPGEN   3392
#define XCD_BAR_WORDS 3456
#define XB_SPIN_CAP (1u << 18)

__device__ __forceinline__ unsigned xb_ld(unsigned* p)              { return __hip_atomic_load(p, __ATOMIC_RELAXED, __HIP_MEMORY_SCOPE_AGENT); }
__device__ __forceinline__ unsigned xb_add(unsigned* p, unsigned v) { return __hip_atomic_fetch_add(p, v, __ATOMIC_RELAXED, __HIP_MEMORY_SCOPE_AGENT); }
__device__ __forceinline__ unsigned xb_xcc_id() { return (unsigned)__builtin_amdgcn_s_getreg((3 << 11) | 20) & 0xFu; }
#define XB_SPIN(cond, bar) do { unsigned _sp = 0; while (cond) { __builtin_amdgcn_s_sleep(1); \
    if ((++_sp & 255u) == 0u) { if (xb_ld(&(bar)[XB_TMO])) break; if (_sp > XB_SPIN_CAP) { atomicAdd(&(bar)[XB_TMO], 1u); break; } } } } while (0)

struct XcdBarrier {
    unsigned* bar; unsigned x;
    volatile LAS unsigned* st;
};

__device__ __forceinline__ XcdBarrier xcd_barrier_post(unsigned* bar, volatile LAS unsigned* st) {
    XcdBarrier b; b.bar = bar; b.x = xb_xcc_id(); b.st = st;
    if (threadIdx.x == 0) (void)xb_add(&bar[XB_XCNT(b.x)], 1u);
    return b;
}
__device__ __forceinline__ void xcd_barrier_complete(unsigned* bar, unsigned x, unsigned& nloc, unsigned& nx) {
    const unsigned G = gridDim.x * gridDim.y * gridDim.z;
    unsigned sum, cnt, mine, sp = 0u;
    for (;;) {
        sum = 0u; cnt = 0u; mine = 0u;
#pragma unroll
        for (unsigned j = 0; j < 16; ++j) { const unsigned c = xb_ld(&bar[XB_XCNT(j)]); sum += c; cnt += (c > 0u) ? 1u : 0u; mine = (j == x) ? c : mine; }
        if (sum == G) break;
        __builtin_amdgcn_s_sleep(1);
        if ((++sp & 255u) == 0u) { if (xb_ld(&bar[XB_TMO])) break; if (sp > XB_SPIN_CAP) { atomicAdd(&bar[XB_TMO], 1u); break; } }
    }
    nloc = mine > 0u ? mine : 1u; nx = cnt > 0u ? cnt : 1u;
}

__device__ __forceinline__ void xcd_barrier(const XcdBarrier& b) {
    asm volatile("s_waitcnt vmcnt(0)" ::: "memory");
    __syncthreads();
    if (threadIdx.x == 0) {
        unsigned* bar = b.bar;
        __builtin_amdgcn_s_waitcnt(0);
        unsigned nloc = b.st[0], nx = b.st[1];
        if (nloc == 0u) { xcd_barrier_complete(bar, b.x, nloc, nx); b.st[0] = nloc; b.st[1] = nx; }
        const unsigned old = xb_add(&bar[XB_XSUB(b.x)], 1u);
        const unsigned gen = old / nloc;
        if (old + 1u == (gen + 1u) * nloc) {
            __builtin_amdgcn_fence(__ATOMIC_RELEASE, "agent");
            asm volatile("s_waitcnt vmcnt(0)" ::: "memory");
            const unsigned og = xb_add(&bar[XB_TOP], 1u);
            const unsigned tg = og / nx;
            if (og + 1u == (tg + 1u) * nx) xb_add(&bar[XB_TOPGEN], 1u);
            else XB_SPIN(xb_ld(&bar[XB_TOPGEN]) == tg, bar);
            __builtin_amdgcn_fence(__ATOMIC_ACQUIRE, "agent");
            xb_add(&bar[XB_XGEN(b.x)], 1u);
            asm volatile("s_waitcnt vmcnt(0)" ::: "memory");
        } else {
            XB_SPIN(xb_ld(&bar[XB_XGEN(b.x)]) == gen, bar);
            __builtin_amdgcn_fence(__ATOMIC_ACQUIRE, "agent");
            asm volatile("s_waitcnt vmcnt(0)" ::: "memory");
        }
    }
    __syncthreads();
}
typedef const __attribute__((address_space(4))) Args* KArgsP;
__device__ __forceinline__ KArgsP kargs() { KArgsP p = (KArgsP)__builtin_amdgcn_kernarg_segment_ptr(); asm volatile("" : "+s"(p)); return p; }
#define KA (kargs())

struct Frame {
    LAS unsigned char* lds;
    volatile LAS unsigned* MISC;
    gu32* ctl;
    int tid, lane, wave;
    int vcu, G;
};
__device__ __forceinline__ float wave_sum(float v) {
#pragma unroll
    for (int o = 1; o < 64; o <<= 1) v += __shfl_xor(v, o);
    return v;
}
__device__ __forceinline__ void p0_transpose_item(const float* W, int K, int N, bf16* WT, int k0, int n0, int dst_row0, const float* gain, LAS float* scr, int lane) {
    const int n = n0 + (lane & 31);
#pragma unroll 8
    for (int i = 0; i < 32; ++i) { const int kk = 2 * i + (lane >> 5); float w = (n < N) ? W[(size_t)(k0 + kk) * N + n] : 0.f; if (gain) w *= gain[k0 + kk]; scr[kk * 33 + (lane & 31)] = w; }
    LDS_WAIT(); asm volatile("" ::: "memory");
    const int c = lane & 7;
#pragma unroll
    for (int j = 0; j < 4; ++j) { const int nn = (lane >> 3) + 8 * j; const LAS float* s = scr + (8 * c) * 33 + nn;
        v4u o; o.x = pk2(s[0 * 33], s[1 * 33]); o.y = pk2(s[2 * 33], s[3 * 33]); o.z = pk2(s[4 * 33], s[5 * 33]); o.w = pk2(s[6 * 33], s[7 * 33]);
        *(GAS v4u*)(WT + (size_t)(dst_row0 + nn) * K + k0 + 8 * c) = o; }
    LDS_WAIT(); asm volatile("" ::: "memory");
}
__device__ __forceinline__ float cos_rev(float r) { return __builtin_amdgcn_cosf(r - floorf(r)); }
__device__ __forceinline__ float sin_rev(float r) { return __builtin_amdgcn_sinf(r - floorf(r)); }
constexpr float INV_2PI = 0.15915494309189535f;

__device__ __forceinline__ void s5_prep(Frame& F, int j, int g) { const KArgsP a = KA;
    LAS float* L = (LAS float*)(F.lds + RING_OFF);
    LAS float* APr = L; LAS float* APi = L + 17 * 64; LAS float* BBr = L + 2 * 17 * 64; LAS float* BBi = BBr + 1024; LAS float* CCr = BBi + 1024; LAS float* CCi = CCr + 1024; LAS float* KK = CCi + 1024;
    const int tid = F.tid; const int jg = j * 64 + g;
    const float dt = __expf(a->in[4][jg]);
    for (int idx = tid; idx < 17 * 64; idx += 512) { const int jj = idx >> 6, p = idx & 63; const float are = a->in[2][jg * 64 + p], aim = a->in[3][jg * 64 + p];
        const float mag = __expf(are * dt * (float)jj), rev = aim * dt * (float)jj * INV_2PI; APr[idx] = mag * cos_rev(rev); APi[idx] = mag * sin_rev(rev); }
    for (int idx = tid; idx < 1024; idx += 512) { const int p = idx >> 4; const float are = a->in[2][jg * 64 + p], aim = a->in[3][jg * 64 + p];
        const float x = are * dt, rev = aim * dt * INV_2PI;
        const float em1 = x * (1.f + x * (0.5f + x * (0.16666667f + x * (0.041666668f + x * 0.008333334f))));
        const float c = cos_rev(rev), s = sin_rev(rev), sh = sin_rev(0.5f * rev);
        const float nr = em1 * c - 2.f * sh * sh, ni = (em1 + 1.f) * s;
        const float den = 1.f / (are * are + aim * aim), qr = (nr * are + ni * aim) * den, qi = (ni * are - nr * aim) * den;
        const float br = a->in[5][(size_t)jg * 1024 + idx], bi = a->in[6][(size_t)jg * 1024 + idx];
        BBr[idx] = qr * br - qi * bi; BBi[idx] = qr * bi + qi * br;
        CCr[idx] = a->in[7][(size_t)jg * 1024 + idx]; CCi[idx] = a->in[8][(size_t)jg * 1024 + idx]; }
    LDS_WAIT(); __syncthreads();
    { const int h = (tid >> 4) & 15, hp = tid & 15, j0 = (tid >> 8) * 8; float accj[8];
#pragma unroll
        for (int q = 0; q < 8; ++q) accj[q] = 0.f;
        for (int p = 0; p < 64; ++p) { const float cr = CCr[h * 64 + p], ci = CCi[h * 64 + p], br = BBr[p * 16 + hp], bi = BBi[p * 16 + hp];
            const float er = cr * br - ci * bi, ei = cr * bi + ci * br;
#pragma unroll
            for (int q = 0; q < 8; ++q) accj[q] += er * APr[(j0 + q) * 64 + p] - ei * APi[(j0 + q) * 64 + p]; }
#pragma unroll
        for (int q = 0; q < 8; ++q) KK[(j0 + q) * 256 + h * 16 + hp] = accj[q]; }
    LDS_WAIT(); __syncthreads();
    bf16* Bm = (bf16*)(a->ws + WS_S5BM) + (size_t)jg * 256 * 384;
    for (int pc = tid; pc < 256 * 48; pc += 512) { const int row = pc / 48, cp = pc % 48, t = row >> 4, h = row & 15, c0 = cp * 8; float v[8];
        if (c0 < 256) { const int s = c0 >> 4, hp0 = c0 & 15;
#pragma unroll
            for (int e = 0; e < 8; ++e) v[e] = (s <= t) ? KK[(t - s) * 256 + h * 16 + hp0 + e] : 0.f;
        } else { const int pp = c0 - 256;
#pragma unroll
            for (int e = 0; e < 8; ++e) { const int p = (pp + e) & 63; const float cr = CCr[h * 64 + p], ci = CCi[h * 64 + p], ar = APr[(t + 1) * 64 + p], ai = APi[(t + 1) * 64 + p];
                v[e] = (pp < 64) ? (cr * ar - ci * ai) : -(cr * ai + ci * ar); } }
        v4u o; o.x = pk2(v[0], v[1]); o.y = pk2(v[2], v[3]); o.z = pk2(v[4], v[5]); o.w = pk2(v[6], v[7]);
        *(GAS v4u*)(Bm + (size_t)row * 384 + c0) = o; }
    bf16* Bs = (bf16*)(a->ws + WS_S5BS) + (size_t)jg * 256 * 256;
    for (int pc = tid; pc < 256 * 32; pc += 512) { const int row = pc >> 5, cp = pc & 31, c0 = cp * 8, s = c0 >> 4, hp0 = c0 & 15; float v[8];
        if (row < 128) { const int p = row & 63; const float ar = APr[(15 - s) * 64 + p], ai = APi[(15 - s) * 64 + p];
#pragma unroll
            for (int e = 0; e < 8; ++e) { const float br = BBr[p * 16 + hp0 + e], bi = BBi[p * 16 + hp0 + e]; v[e] = (row < 64) ? (ar * br - ai * bi) : (ar * bi + ai * br); }
        } else {
#pragma unroll
            for (int e = 0; e < 8; ++e) v[e] = 0.f; }
        v4u o; o.x = pk2(v[0], v[1]); o.y = pk2(v[2], v[3]); o.z = pk2(v[4], v[5]); o.w = pk2(v[6], v[7]);
        *(GAS v4u*)(Bs + (size_t)row * 256 + c0) = o; }
    LDS_WAIT(); __syncthreads();
}

__device__ __forceinline__ void norm_pass(Frame& F, const float* hsrc, float* hdst, const bf16* mix, const float* gpost, int premode, const float* gpre, bf16* XN, bf16* AS5) {
    const int gw = F.vcu * NWAVES + F.wave, NGW = F.G * NWAVES; int lane_ = F.lane; asm volatile("" : "+v"(lane_)); const int lane = lane_;
    for (int m = gw; m < M; m += NGW) {
        const GAS f32x4* xr = (const GAS f32x4*)(hsrc + (size_t)m * D) + lane;
        f32x4 v[4];
#pragma unroll
        for (int j = 0; j < 4; ++j) v[j] = xr[64 * j];
        if (mix) {
            const GAS unsigned long long* mr = (const GAS unsigned long long*)(mix + (size_t)m * D) + lane;
            f32x4 x[4]; float s = 0.f;
#pragma unroll
            for (int j = 0; j < 4; ++j) { const unsigned long long w = mr[64 * j]; const unsigned lo = (unsigned)w, hi = (unsigned)(w >> 32);
                x[j] = (f32x4){__uint_as_float(lo << 16), __uint_as_float(lo & 0xffff0000u), __uint_as_float(hi << 16), __uint_as_float(hi & 0xffff0000u)};
                s += (x[j].x * x[j].x + x[j].y * x[j].y) + (x[j].z * x[j].z + x[j].w * x[j].w); }
            const float r = 1.f / sqrtf(wave_sum(s) * (1.f / D) + RMS_EPS);
            GAS f32x4* orow = (GAS f32x4*)(hdst + (size_t)m * D) + lane;
#pragma unroll
            for (int j = 0; j < 4; ++j) { const f32x4 gp = *((const GAS f32x4*)gpost + lane + 64 * j); v[j] = v[j] + x[j] * r * gp; orow[64 * j] = v[j]; }
        } else if (hdst != hsrc) {
            GAS f32x4* orow = (GAS f32x4*)(hdst + (size_t)m * D) + lane;
#pragma unroll
            for (int j = 0; j < 4; ++j) orow[64 * j] = v[j];
        }
        if (premode) {
            float s2 = 0.f;
#pragma unroll
            for (int j = 0; j < 4; ++j) s2 += (v[j].x * v[j].x + v[j].y * v[j].y) + (v[j].z * v[j].z + v[j].w * v[j].w);
            const float inv = 1.f / sqrtf(wave_sum(s2) * (1.f / D) + RMS_EPS);
            if (premode == 1) {
                GAS unsigned long long* o8 = (GAS unsigned long long*)(XN + (size_t)m * D) + lane;
#pragma unroll
                for (int j = 0; j < 4; ++j) o8[64 * j] = (unsigned long long)pk2(v[j].x * inv, v[j].y * inv) | ((unsigned long long)pk2(v[j].z * inv, v[j].w * inv) << 32);
            } else {
                const int sc = m >> 4, t = m & 15;
#pragma unroll
                for (int j = 0; j < 4; ++j) { const f32x4 gp = *((const GAS f32x4*)gpre + lane + 64 * j); const f32x4 w = v[j] * inv * gp;
                    const int g = (lane >> 2) + 16 * j;
                    GAS unsigned long long* o8 = (GAS unsigned long long*)(AS5 + ((size_t)g * NSC + sc) * S5KA + t * 16 + 4 * (lane & 3));
                    *o8 = (unsigned long long)pk2(w.x, w.y) | ((unsigned long long)pk2(w.z, w.w) << 32); }
            }
        }
    }
}

__device__ __forceinline__ void s5_carry(Frame& F, int j) { const KArgsP a = KA;
    if (F.wave < 2) {
        int p_ = F.lane; asm volatile("" : "+v"(p_)); const int item = F.wave * 256 + (int)blockIdx.x; const int g = item >> 3, b = item & 7, p = p_; const int jg = j * 64 + g;
        const float dt = __expf(a->in[4][jg]); const float are = a->in[2][jg * 64 + p], aim = a->in[3][jg * 64 + p];
        const float mag = __expf(are * dt * 16.f), rev = aim * dt * 16.f * INV_2PI; const float ar = mag * cos_rev(rev), ai = mag * sin_rev(rev);
        const float* SL = (const float*)(a->ws + WS_SL) + ((size_t)g * NSC + b * 256) * 128;
        bf16* AS = (bf16*)(a->ws + WS_AS5) + ((size_t)g * NSC + b * 256) * S5KA + 256;
        float xr = 0.f, xi = 0.f;
#pragma unroll 16
        for (int sc = 0; sc < 256; ++sc) {
            const float lr = SL[(size_t)sc * 128 + p], li = SL[(size_t)sc * 128 + 64 + p];
            AS[(size_t)sc * S5KA + p] = (bf16)f2bf(xr); AS[(size_t)sc * S5KA + 64 + p] = (bf16)f2bf(xi);
            const float nr = ar * xr - ai * xi + lr, ni = ar * xi + ai * xr + li; xr = nr; xi = ni;
        }
    }
}

__device__ __forceinline__ void fox_cumsum(Frame& F) { const KArgsP a = KA;
    if (blockIdx.x < NB * H) {
        int tid_ = F.tid; asm volatile("" : "+v"(tid_)); const int bh = blockIdx.x, b = bh >> 4, h = bh & 15, tid = tid_; const int lane_ = tid & 63;
        const float* LF = (const float*)(a->ws + WS_LF) + ((size_t)b * T + 8 * tid) * 16 + h;
        float v[8]; float run = 0.f;
#pragma unroll
        for (int i = 0; i < 8; ++i) { run += LF[i * 16]; v[i] = run; }
        float x = run;
#pragma unroll
        for (int o = 1; o < 64; o <<= 1) { const float tt = __shfl_up(x, o); if (lane_ >= o) x += tt; }
        LAS float* wt = (LAS float*)(F.lds + RING_OFF);
        if (lane_ == 63) wt[F.wave] = x;
        LDS_WAIT(); __syncthreads();
        float pre = x - run;
        for (int w = 0; w < F.wave; ++w) pre += wt[w];
        float* o = (float*)(a->ws + WS_CK2) + (size_t)bh * T + 8 * tid;
        const float L2E = 1.4426950408889634f;
        *(f32x4*)o = (f32x4){(pre + v[0]) * L2E, (pre + v[1]) * L2E, (pre + v[2]) * L2E, (pre + v[3]) * L2E};
        *(f32x4*)(o + 4) = (f32x4){(pre + v[4]) * L2E, (pre + v[5]) * L2E, (pre + v[6]) * L2E, (pre + v[7]) * L2E};
        LDS_WAIT(); __syncthreads();
    }
}

__device__ __forceinline__ void p0_prologue(Frame& F) {
    if (blockIdx.x < 128) s5_prep(F, (int)blockIdx.x >> 6, (int)blockIdx.x & 63);
    const KArgsP a = KA;
    LAS float* scr = (LAS float*)(F.lds + RING_OFF + F.wave * 16384);
    const int gw = F.vcu * NWAVES + F.wave, NGW = F.G * NWAVES;
    const float* gains = a->in[1];
    constexpr int I_GLU = 16 * 64, I_WIN = 16 * 129, I_WOUT = 16 * 32, I_W1 = 16 * 128, I_W2 = 64 * 32, I_Z = 224;
    constexpr int NITEMS = 2 * I_GLU + 2 * I_WIN + 2 * I_WOUT + 4 * I_W1 + 4 * I_W2 + 2 * I_Z;
    for (int it = gw; it < NITEMS; it += NGW) {
        int r = it;
        if (r < 2 * I_GLU) { const int j = r / I_GLU; r -= j * I_GLU; const int kb = r >> 6, nb = r & 63, n0 = nb * 32;
            const int dst = (n0 < 1024) ? ((n0 >> 7) * 256 + (n0 & 127)) : ((((n0 - 1024) >> 7) * 256) + 128 + ((n0 - 1024) & 127));
            p0_transpose_item(a->in[10] + (size_t)j * 1024 * 2048, 1024, 2048, (bf16*)(a->ws + WS_WGLU) + (size_t)j * 2048 * 1024, kb * 64, n0, dst, nullptr, scr, F.lane); continue; }
        r -= 2 * I_GLU;
        if (r < 2 * I_WIN) { const int j = r / I_WIN; r -= j * I_WIN; const int kb = r / 129, nb = r % 129, n0 = nb * 32;
            p0_transpose_item(a->in[11] + (size_t)j * 1024 * NPROJ_REAL, 1024, NPROJ_REAL, (bf16*)(a->ws + WS_WIN) + (size_t)j * NPROJ * 1024, kb * 64, n0, n0, gains + (size_t)(2 * j + 1) * 4 * D, scr, F.lane); continue; }
        r -= 2 * I_WIN;
        if (r < 2 * I_WOUT) { const int j = r / I_WOUT; r -= j * I_WOUT; const int kb = r >> 5, nb = r & 31, n0 = nb * 32;
            p0_transpose_item(a->in[13] + (size_t)j * 1024 * 1024, 1024, 1024, (bf16*)(a->ws + WS_WOUT) + (size_t)j * 1024 * 1024, kb * 64, n0, n0, nullptr, scr, F.lane); continue; }
        r -= 2 * I_WOUT;
        if (r < 4 * I_W1) { const int i = r / I_W1; r -= i * I_W1; const int kb = r >> 7, nb = r & 127, n0 = nb * 32;
            p0_transpose_item(a->in[14] + (size_t)i * 1024 * 4096, 1024, 4096, (bf16*)(a->ws + WS_W1) + (size_t)i * 4096 * 1024, kb * 64, n0, n0, gains + (size_t)i * 4 * D + 2 * D, scr, F.lane); continue; }
        r -= 4 * I_W1;
        if (r < 4 * I_W2) { const int i = r / I_W2; r -= i * I_W2; const int kb = r >> 5, nb = r & 31, n0 = nb * 32;
            p0_transpose_item(a->in[15] + (size_t)i * 4096 * 1024, 4096, 1024, (bf16*)(a->ws + WS_W2) + (size_t)i * 1024 * 4096, kb * 64, n0, n0, nullptr, scr, F.lane); continue; }
        r -= 4 * I_W2;
        { const int j = r / I_Z; r -= j * I_Z;
            GAS v4u* zr = (GAS v4u*)((bf16*)(a->ws + WS_WIN) + ((size_t)j * NPROJ + 4128 + r) * 1024) + F.lane; const v4u z = {0u, 0u, 0u, 0u}; zr[0] = z; zr[64] = z; }
    }
    norm_pass(F, a->in[0], (float*)a->in[0], nullptr, nullptr, 2, gains, nullptr, (bf16*)(a->ws + WS_AS5));
}

__global__ void __launch_bounds__(NWAVES * 64, 2) mk_fwd(Args args_unused) {
    extern __shared__ __attribute__((aligned(16))) unsigned char lds[];
    Frame F;
    F.lds = (LAS unsigned char*)lds;
    F.MISC = (volatile LAS unsigned*)(F.lds + MISC_OFF);
    F.tid = threadIdx.x; F.lane = F.tid & 63; F.wave = __builtin_amdgcn_readfirstlane(F.tid >> 6);
    F.G = gridDim.x; { const int bx = blockIdx.x; F.vcu = (F.G % 8 == 0) ? (bx % 8) * (F.G / 8) + bx / 8 : bx; }
    F.ctl = (gu32*)(KA->ws + WS_CTL);
    for (int u = F.tid; u < (LDS_BYTES - LDSCTL_OFF) / 4; u += NWAVES * 64) ((LAS unsigned*)(F.lds + LDSCTL_OFF))[u] = 0u;
    __syncthreads();
    XcdBarrier bar = xcd_barrier_post((unsigned*)(F.ctl + CW_BAR), F.MISC + 8);
#define GRID_BAR() do { XcdBarrier b_ = bar; asm volatile("" : "+s"(b_.bar), "+s"(b_.x)); xcd_barrier(b_); } while (0)
#define WSP(T_, off) ((T_*)(KA->ws + (off)))
#define GAINS(i_, k_) (KA->in[1] + (size_t)(i_) * 4 * D + (size_t)(k_) * D)

#ifndef SKIP_PRO
    p0_prologue(F);
#endif
    cooperative_groups::this_grid().sync();
    GRID_BAR();
#if NSUB == 0
    norm_pass(F, KA->in[0], KA->out, nullptr, nullptr, 0, nullptr, nullptr, nullptr);
#else
    for (int i = 0; i < DEPTH; ++i) {
        if (2 * i >= NSUB) break;
        const int j = i >> 1;
        if ((i & 1) == 0) {
#ifndef SKIP_S5LOC
            { pg8::Gemm g{WSP(const bf16, WS_AS5), WSP(const bf16, WS_S5BS) + (size_t)j * 64 * 256 * 256, 64 * NSC, 256, 256, S5KA, 256}; pg8::S5Order S; S.init(F.G, (int)blockIdx.x);
              pg8::EpiS5Loc E{WSP(float, WS_SL)};
              pg8::gemm_phase<pg8::EpiS5Loc, pg8::S5Order, true, true>(F.lds + RING_OFF, g, S, E); }
#endif
            GRID_BAR();
#ifndef SKIP_CARRY
            s5_carry(F, j);
#endif
            GRID_BAR();
#ifndef SKIP_S5MAIN
            { pg8::Gemm g{WSP(const bf16, WS_AS5), WSP(const bf16, WS_S5BM) + (size_t)j * 64 * 256 * 384, 64 * NSC, 256, 384, S5KA, 384}; pg8::S5Order S; S.init(F.G, (int)blockIdx.x);
              pg8::EpiS5Main E{WSP(bf16, WS_G), WSP(const bf16, WS_AS5), KA->in[9] + (size_t)j * D};
              pg8::gemm_phase<pg8::EpiS5Main, pg8::S5Order, true, true>(F.lds + RING_OFF, g, S, E); }
#endif
            GRID_BAR();
#ifndef SKIP_GLU
            { pg8::Gemm g{WSP(const bf16, WS_G), WSP(const bf16, WS_WGLU) + (size_t)j * 2048 * 1024, M, 2048, D, D, D}; pg8::StaticOrder S; S.init(M, 2048, F.G, (int)blockIdx.x);
              pg8::EpiGLU E{WSP(bf16, WS_XN), D};
              pg8::gemm_phase<pg8::EpiGLU, pg8::StaticOrder, true, true>(F.lds + RING_OFF, g, S, E); }
#endif
        } else {
#ifndef SKIP_PROJ
            { pg8::Gemm g{WSP(const bf16, WS_XN), WSP(const bf16, WS_WIN) + (size_t)j * NPROJ * 1024, M, NPROJ, D, D, D}; pg8::StaticOrder S; S.init(M, NPROJ, F.G, (int)blockIdx.x);
              pg8::EpiProj E{WSP(bf16, WS_Q), (size_t)M * D, WSP(float, WS_LF), KA->in[12] + (size_t)j * H, attn_body::C2};
              pg8::gemm_phase<pg8::EpiProj, pg8::StaticOrder, true, true>(F.lds + RING_OFF, g, S, E); }
#endif
            GRID_BAR();
#ifndef SKIP_CUMSUM
            fox_cumsum(F);
#endif
            GRID_BAR();
#ifndef SKIP_ATTN
            { const attn_body::AttnTensors AT{WSP(const attn_body::bf16, WS_Q), WSP(const attn_body::bf16, WS_K), WSP(const attn_body::bf16, WS_V), WSP(const attn_body::bf16, WS_GATE), WSP(const float, WS_CK2), WSP(attn_body::bf16, WS_Q)};
              const attn_body::StaticOrder S((int)F.G, (int)blockIdx.x);
              attn_body::attn_phase<attn_body::StaticOrder>((char*)lds + RING_OFF, AT, S); }
#endif
            GRID_BAR();
#ifndef SKIP_WO
            { pg8::Gemm g{WSP(const bf16, WS_Q), WSP(const bf16, WS_WOUT) + (size_t)j * 1024 * 1024, M, D, D, D, D}; pg8::StaticOrder S; S.init(M, D, F.G, (int)blockIdx.x);
              pg8::EpiPlain E{WSP(bf16, WS_XN), D};
              pg8::gemm_phase<pg8::EpiPlain, pg8::StaticOrder, true, true>(F.lds + RING_OFF, g, S, E); }
#endif
        }
        GRID_BAR();
        const bool lastsub = (2 * i + 1 >= NSUB);
        norm_pass(F, i == 0 ? KA->in[0] : (const float*)KA->out, KA->out, WSP(const bf16, WS_XN), GAINS(i, 1), lastsub ? 0 : 1, nullptr, WSP(bf16, WS_XN), nullptr);
        if (lastsub) break;
        GRID_BAR();
#ifndef SKIP_MLP
        { pg8::Gemm g{WSP(const bf16, WS_XN), WSP(const bf16, WS_W1) + (size_t)i * 4096 * 1024, M, FF, D, D, D}; pg8::StaticOrder S; S.init(M, FF, F.G, (int)blockIdx.x);
          pg8::EpiRelu2 E{WSP(bf16, WS_BIG), FF};
          pg8::gemm_phase<pg8::EpiRelu2, pg8::StaticOrder, true, true>(F.lds + RING_OFF, g, S, E); }
        GRID_BAR();
        { pg8::Gemm g{WSP(const bf16, WS_BIG), WSP(const bf16, WS_W2) + (size_t)i * 1024 * 4096, M, D, FF, FF, FF}; pg8::StaticOrder S; S.init(M, D, F.G, (int)blockIdx.x);
          pg8::EpiPlain E{WSP(bf16, WS_XN), D};
          pg8::gemm_phase<pg8::EpiPlain, pg8::StaticOrder, true, true>(F.lds + RING_OFF, g, S, E); }
#endif
        GRID_BAR();
        const bool fin = (2 * i + 2 >= NSUB) || (i == DEPTH - 1);
        const int premode = fin ? 0 : (((i + 1) & 1) == 0 ? 2 : 1);
        norm_pass(F, KA->out, KA->out, WSP(const bf16, WS_XN), GAINS(i, 3), premode, GAINS(i + 1 < DEPTH ? i + 1 : i, 0), WSP(bf16, WS_XN), WSP(bf16, WS_AS5));
        if (fin) break;
        GRID_BAR();
    }
#endif
}

extern "C" void kernel_launch(void* const* d_in, const int* in_sizes, int n_in, void* d_out, int out_size, void* d_ws, size_t ws_size, hipStream_t stream) {
    static int grid = 0;
    if (grid == 0) {
        if (n_in != 16 || in_sizes[0] != M * D || out_size != M * D || ws_size < WS_END) { fprintf(stderr, "kernel_launch: unexpected shapes (n_in %d, in0 %d, out %d, ws %zu); nothing launched\n", n_in, n_in > 0 ? in_sizes[0] : -1, out_size, ws_size); grid = -1; return; }
        int dev = 0, cus = 0, per_cu = 0;
        if (hipGetDevice(&dev) != hipSuccess || hipDeviceGetAttribute(&cus, hipDeviceAttributeMultiprocessorCount, dev) != hipSuccess) { grid = -1; return; }
        if (hipFuncSetAttribute((const void*)mk_fwd, hipFuncAttributeMaxDynamicSharedMemorySize, LDS_BYTES) != hipSuccess) { fprintf(stderr, "kernel_launch: hipFuncSetAttribute failed\n"); grid = -1; return; }
        if (hipOccupancyMaxActiveBlocksPerMultiprocessor(&per_cu, (const void*)mk_fwd, NWAVES * 64, LDS_BYTES) != hipSuccess || per_cu < 1) { fprintf(stderr, "kernel_launch: occupancy query says %d\n", per_cu); per_cu = 1; }
        (void)hipGetLastError();
        grid = cus;
    }
    if (grid < 0) return;
    if (hipMemsetAsync((char*)d_ws + WS_CTL, 0, CTL_ZERO_BYTES, stream) != hipSuccess) { fprintf(stderr, "kernel_launch: hipMemsetAsync failed\n"); return; }
    Args a{};
    for (int i = 0; i < 16; ++i) a.in[i] = (const float*)d_in[i];
    a.out = (float*)d_out; a.ws = (unsigned char*)d_ws;
    void* kargv[] = {&a};
    const hipError_t le = hipLaunchCooperativeKernel((const void*)mk_fwd, dim3(grid), dim3(NWAVES * 64), kargv, LDS_BYTES, stream);
    if (le != hipSuccess) fprintf(stderr, "kernel_launch: cooperative launch failed: %s (grid %d)\n", hipGetErrorName(le), grid);
}
```

```cpp
#include <hip/hip_runtime.h>
#include <hip/hip_cooperative_groups.h>
#include <cstdio>
#include <cstdint>
#define NSUB 8
#ifndef PG8_WGM
#define PG8_WGM 8
#endif
namespace pg8 {
#define PG8_LAS __attribute__((address_space(3)))
typedef unsigned short bf16_t;
typedef short bf16x8 __attribute__((ext_vector_type(8)));
typedef float f32x4 __attribute__((ext_vector_type(4)));
typedef unsigned u32x4 __attribute__((ext_vector_type(4)));
constexpr int BM = 256, BK = 64, HALF = 128, HTB = HALF * BK * 2  , STAGE_BYTES = 8 * HTB, NXCD = 8, WGM = 8;

__host__ __device__ __forceinline__ int lds_byte(int r, int c) { const int st = (r >> 4) * 2 + (c >> 5), rr = r & 15, cc = c & 31, ob = rr * 64 + cc * 2; return st * 1024 + (ob ^ (((ob >> 9) & 1) << 5)); }
__host__ __device__ __forceinline__ void stage_rc(int b, int& R, int& C) { const int st = b / 1024, sb = b % 1024, swz = sb ^ (((sb >> 9) & 1) << 5); R = (st >> 1) * 16 + swz / 64; C = (st & 1) * 32 + (swz % 64) / 2; }
__host__ __device__ __forceinline__ int perm32(int rho) { const int n = rho >> 4, i = rho & 15; return 8 * (i >> 2) + 4 * n + (i & 3); }

struct Unit { int pm, pn; };
struct Gemm { const bf16_t* A; const bf16_t* Bt; int M, N, K, lda, ldb, bunit; };

struct StaticOrder {
    int nM, nN, nwg, G, c, wgm;
    __host__ __device__ void init(int M, int N, int G_, int c_, int wgm_ = 4) { nM = M / BM; nN = N / BM; nwg = nM * nN; G = G_; c = c_; wgm = wgm_; }
    __host__ __device__ bool next(int i, Unit& u) const {
        const long L = (long)i * G + c; if (L >= nwg) return false;
        int wgid = (int)L; { const int q = nwg / NXCD, r = nwg % NXCD, xcd = wgid % NXCD, off = wgid / NXCD; wgid = (xcd < r ? xcd * (q + 1) : r * (q + 1) + (xcd - r) * q) + off; }
        const int nig = wgm * nN, gid = wgid / nig, fm = gid * wgm, gsz = (nM - fm) < wgm ? (nM - fm) : wgm;
        u.pm = fm + ((wgid % nig) % gsz); u.pn = (wgid % nig) / gsz; return true;
    }
    __device__ __forceinline__ void a_ready(const Unit&) const {}
    __device__ __forceinline__ void done(const Unit&) const {}
};

__device__ __forceinline__ unsigned cvt_pk_bf16(float lo, float hi) { unsigned r; asm volatile("v_cvt_pk_bf16_f32 %0, %1, %2" : "=v"(r) : "v"(lo), "v"(hi)); return r; }
typedef float f32x2 __attribute__((ext_vector_type(2)));
__device__ __forceinline__ void store8(bf16_t* p, f32x4 v0, f32x4 v1) { u32x4 w; w.x = cvt_pk_bf16(v0[0], v0[1]); w.y = cvt_pk_bf16(v0[2], v0[3]); w.z = cvt_pk_bf16(v1[0], v1[1]); w.w = cvt_pk_bf16(v1[2], v1[3]); *(u32x4*)p = w; }
__device__ __forceinline__ float sigmoidf_(float x) { return __builtin_amdgcn_rcpf(1.0f + __builtin_amdgcn_exp2f(-1.4426950408889634f * x)); }
__device__ __forceinline__ float bf_lo(unsigned w) { return __uint_as_float(w << 16); }
__device__ __forceinline__ float bf_hi(unsigned w) { return __uint_as_float(w & 0xffff0000u); }

struct EpiPlain {
    static constexpr bool PERM = true, AFTER_DRAIN = false;
    bf16_t* O; int ldc;
    __device__ __forceinline__ void operator()(const f32x4 (&acc)[2][2][4][2], const Unit& u, int wr, int wc, int fr, int fq) const {
        const int row0 = u.pm * BM + wr * 64 + fr, col0 = u.pn * BM + wc * 32 + 8 * fq;
#pragma unroll
        for (int ai = 0; ai < 2; ++ai)
#pragma unroll
            for (int m = 0; m < 4; ++m) { bf16_t* rowp = O + (size_t)(row0 + ai * HALF + m * 16) * ldc + col0;
#pragma unroll
                for (int bj = 0; bj < 2; ++bj) store8(rowp + bj * HALF, acc[ai][bj][m][0], acc[ai][bj][m][1]); }
    }
};
struct EpiRelu2 {
    static constexpr bool PERM = true, AFTER_DRAIN = false;
    bf16_t* O; int ldc; const float* rowinv;
    __device__ __forceinline__ void operator()(const f32x4 (&acc)[2][2][4][2], const Unit& u, int wr, int wc, int fr, int fq) const {
        const int row0 = u.pm * BM + wr * 64 + fr, col0 = u.pn * BM + wc * 32 + 8 * fq;
        float invs[2][4];
#pragma unroll
        for (int ai = 0; ai < 2; ++ai)
#pragma unroll
            for (int m = 0; m < 4; ++m) invs[ai][m] = rowinv[row0 + ai * HALF + m * 16];
#pragma unroll
        for (int ai = 0; ai < 2; ++ai)
#pragma unroll
            for (int m = 0; m < 4; ++m) { const int row = row0 + ai * HALF + m * 16; bf16_t* rowp = O + (size_t)row * ldc + col0; const float inv = invs[ai][m];
#pragma unroll
                for (int bj = 0; bj < 2; ++bj) { f32x4 v0 = acc[ai][bj][m][0], v1 = acc[ai][bj][m][1];
#pragma unroll
                    for (int e = 0; e < 4; ++e) { const float a = fmaxf(v0[e], 0.f) * inv, b = fmaxf(v1[e], 0.f) * inv; v0[e] = a * a; v1[e] = b * b; }
                    store8(rowp + bj * HALF, v0, v1); } }
    }
};
struct EpiGLU {
    static constexpr bool PERM = true, AFTER_DRAIN = false;
    bf16_t* O; int ldc;
    __device__ __forceinline__ void operator()(const f32x4 (&acc)[2][2][4][2], const Unit& u, int wr, int wc, int fr, int fq) const {
        const int row0 = u.pm * BM + wr * 64 + fr, col0 = u.pn * HALF + wc * 32 + 8 * fq;
#pragma unroll
        for (int ai = 0; ai < 2; ++ai)
#pragma unroll
            for (int m = 0; m < 4; ++m) { bf16_t* rowp = O + (size_t)(row0 + ai * HALF + m * 16) * ldc + col0;
                f32x4 v0 = acc[ai][0][m][0], v1 = acc[ai][0][m][1]; const f32x4 g0 = acc[ai][1][m][0], g1 = acc[ai][1][m][1];
#pragma unroll
                for (int e = 0; e < 4; ++e) { v0[e] *= sigmoidf_(g0[e]); v1[e] *= sigmoidf_(g1[e]); }
                store8(rowp, v0, v1); }
    }
};
struct EpiProj {
    static constexpr bool PERM = true, AFTER_DRAIN = false;
    bf16_t* QKVG; size_t stride; float qscale; const float* rowinv;
    __device__ __forceinline__ void operator()(const f32x4 (&acc)[2][2][4][2], const Unit& u, int wr, int wc, int fr, int fq) const {
        const int row0 = u.pm * BM + wr * 64 + fr;
        float invs[2][4];
#pragma unroll
        for (int ai = 0; ai < 2; ++ai)
#pragma unroll
            for (int m = 0; m < 4; ++m) invs[ai][m] = rowinv[row0 + ai * HALF + m * 16];
        const int t = u.pn >> 2; bf16_t* base = QKVG + (size_t)t * stride; const int col0 = (u.pn & 3) * BM + wc * 32 + 8 * fq; const float sc = (t == 0) ? qscale : 1.0f;
#pragma unroll
        for (int ai = 0; ai < 2; ++ai)
#pragma unroll
            for (int m = 0; m < 4; ++m) { const int row = row0 + ai * HALF + m * 16; bf16_t* rowp = base + (size_t)row * 1024 + col0; const float sci = sc * invs[ai][m];
#pragma unroll
                for (int bj = 0; bj < 2; ++bj) store8(rowp + bj * HALF, acc[ai][bj][m][0] * sci, acc[ai][bj][m][1] * sci); }
    }
};
struct EpiS5Loc {
    static constexpr bool PERM = true, AFTER_DRAIN = false;
    float* SL;
    __device__ __forceinline__ void operator()(const f32x4 (&acc)[2][2][4][2], const Unit& u, int wr, int wc, int fr, int fq) const {
        const int row0 = u.pm * BM + wr * 64 + fr, col0 = wc * 32 + 8 * fq;
#pragma unroll
        for (int ai = 0; ai < 2; ++ai)
#pragma unroll
            for (int m = 0; m < 4; ++m) { float* rowp = SL + (size_t)(row0 + ai * HALF + m * 16) * 128 + col0; *(f32x4*)rowp = acc[ai][0][m][0]; *(f32x4*)(rowp + 4) = acc[ai][0][m][1]; }
    }
};
struct EpiS5Main {
    static constexpr bool PERM = true, AFTER_DRAIN = false;
    bf16_t* G; const bf16_t* AS5; const float* dskip;
    __device__ __forceinline__ void operator()(const f32x4 (&acc)[2][2][4][2], const Unit& u, int wr, int wc, int fr, int fq) const {
        const int g = u.pn, row0 = u.pm * BM + wr * 64 + fr;
        const int ch0 = g * 16 + 8 * (fq & 1);
        const f32x4 d0 = *(const f32x4*)(dskip + ch0), d1 = *(const f32x4*)(dskip + ch0 + 4);
#pragma unroll
        for (int ai = 0; ai < 2; ++ai) { u32x4 uus[4][2];
#pragma unroll
            for (int m = 0; m < 4; ++m)
#pragma unroll
                for (int bj = 0; bj < 2; ++bj) uus[m][bj] = *(const u32x4*)(AS5 + (size_t)(row0 + ai * HALF + m * 16) * 384 + bj * HALF + wc * 32 + 8 * fq);
#pragma unroll
            for (int m = 0; m < 4; ++m) { const int row = row0 + ai * HALF + m * 16; const int scl = row - g * 2048;
#pragma unroll
                for (int bj = 0; bj < 2; ++bj) { const int c0 = bj * HALF + wc * 32 + 8 * fq; const int t = c0 >> 4;
                    const u32x4 uu = uus[m][bj];
                    f32x4 y0 = acc[ai][bj][m][0], y1 = acc[ai][bj][m][1];
                    y0[0] += d0[0] * bf_lo(uu.x); y0[1] += d0[1] * bf_hi(uu.x); y0[2] += d0[2] * bf_lo(uu.y); y0[3] += d0[3] * bf_hi(uu.y);
                    y1[0] += d1[0] * bf_lo(uu.z); y1[1] += d1[1] * bf_hi(uu.z); y1[2] += d1[2] * bf_lo(uu.w); y1[3] += d1[3] * bf_hi(uu.w);
#pragma unroll
                    for (int e = 0; e < 4; ++e) { const float a = y0[e], b = y1[e];
                        y0[e] = a * sigmoidf_(1.5957691216057308f * (a + 0.044715f * a * a * a)); y1[e] = b * sigmoidf_(1.5957691216057308f * (b + 0.044715f * b * b * b)); }
                    store8(G + ((size_t)scl * 16 + t) * 1024 + ch0, y0, y1); } }
            asm volatile("" ::: "memory"); }
    }
};
struct S5Order {
    int G, c;
    __host__ __device__ void init(int G_, int c_) { G = G_; c = c_; }
    __host__ __device__ bool next(int i, Unit& u) const { const int L = i * G + c; if (L >= 512) return false; u.pm = L; u.pn = L >> 3; return true; }
    __device__ __forceinline__ void a_ready(const Unit&) const {}
    __device__ __forceinline__ void done(const Unit&) const {}
};

struct EpiS5LocCarry {
    static constexpr bool PERM = true, AFTER_DRAIN = true;
    bf16_t* AS5; const float* a_re; const float* a_im; const float* log_dt;
    __device__ __forceinline__ void fused(f32x4 (&acc)[2][2][4][2], const Unit& u, int wr, int wc, int fr, int fq, PG8_LAS unsigned char* lds, int wid, int lane) const {
        PG8_LAS float* T = (PG8_LAS float*)lds;
        const int col0 = wc * 32 + 8 * fq;
#pragma unroll
        for (int ai = 0; ai < 2; ++ai)
#pragma unroll
            for (int m = 0; m < 4; ++m) { PG8_LAS float* rowp = T + (ai * HALF + wr * 64 + m * 16 + fr) * 128 + col0; *(PG8_LAS f32x4*)rowp = acc[ai][0][m][0]; *(PG8_LAS f32x4*)(rowp + 4) = acc[ai][0][m][1]; }
        asm volatile("s_waitcnt lgkmcnt(0)" ::: "memory"); __builtin_amdgcn_s_barrier(); asm volatile("" ::: "memory");
        if (wid == 0) {
            const int g = u.pn, p = lane;
            const float dt = __expf(log_dt[g]); const float are = a_re[g * 64 + p], aim = a_im[g * 64 + p];
            const float mag = __expf(are * dt * 16.f), rev = aim * dt * 16.f * 0.15915494309189535f, rf = rev - floorf(rev);
            const float ar = mag * __builtin_amdgcn_cosf(rf), ai = mag * __builtin_amdgcn_sinf(rf);
            __attribute__((address_space(1))) bf16_t* AS = (__attribute__((address_space(1))) bf16_t*)(AS5 + (size_t)u.pm * BM * 384 + 256);
            float xr = 0.f, xi = 0.f;
#pragma unroll 8
            for (int sc = 0; sc < 256; ++sc) {
                const float lr = T[sc * 128 + p], li = T[sc * 128 + 64 + p];
                AS[(size_t)sc * 384 + p] = (bf16_t)(cvt_pk_bf16(xr, xr) & 0xffffu); AS[(size_t)sc * 384 + 64 + p] = (bf16_t)(cvt_pk_bf16(xi, xi) & 0xffffu);
                const float nr = ar * xr - ai * xi + lr, ni = ar * xi + ai * xr + li; xr = nr; xi = ni;
            }
        }
        asm volatile("s_waitcnt lgkmcnt(0)" ::: "memory"); __builtin_amdgcn_s_barrier(); asm volatile("" ::: "memory");
    }
};
struct S5OneOrder {
    int L;
    __host__ __device__ bool next(int i, Unit& u) const { if (i > 0 || L >= 512) return false; u.pm = L; u.pn = L >> 3; return true; }
    __device__ __forceinline__ void a_ready(const Unit&) const {}
    __device__ __forceinline__ void done(const Unit&) const {}
};

template <class Epi, class Sched, bool ALIGN_EPI = false, bool SP2 = false>
__device__ __forceinline__ void gemm_phase(PG8_LAS unsigned char* lds, const Gemm g, const Sched& S, const Epi& E) {
    int tid_ = threadIdx.x; asm volatile("" : "+v"(tid_)); const int tid = tid_, wid = __builtin_amdgcn_readfirstlane(tid >> 6), lane = tid & 63, wr = wid >> 2, wc = wid & 3, fr = lane & 15, fq = lane >> 4;
    const int K = g.K, nt = K / BK;
    unsigned voffA[2], voffB[2];
#pragma unroll
    for (int i = 0; i < 2; ++i) { int R, C; stage_rc(tid * 16 + i * 8192, R, C); const int Rb = Epi::PERM ? ((R & ~31) + perm32(R & 31)) : R;
        voffA[i] = (unsigned)(R * g.lda + C) * 2u; voffB[i] = (unsigned)(Rb * g.ldb + C) * 2u; }
    const size_t kstep = (size_t)(BK * 2);
    const size_t hstepA = (size_t)HALF * g.lda * 2, hstepB = (size_t)HALF * g.ldb * 2;
    const size_t tstepA = 2 * hstepA, tstepB = (size_t)g.bunit * g.ldb * 2;
    const unsigned ldsw = (unsigned)wid * 1024u;
    const int aoff = lds_byte(wr * 64 + fr, fq * 8), boff = lds_byte(wc * 32 + fr, fq * 8);
#define PG8_SA(b, h) (((b) * 2 + (h)) * HTB)
#define PG8_SB(b, h) ((4 + (b) * 2 + (h)) * HTB)
#define PG8_STAGE(bufoff, gbase, voff) do { _Pragma("unroll") for (int _i = 0; _i < 2; ++_i) \
        __builtin_amdgcn_global_load_lds((const unsigned*)((const char*)(gbase) + (voff)[_i]), (PG8_LAS unsigned*)(lds + (bufoff) + ldsw + _i * 8192), 16, 0, 0); } while (0)
#define PG8_LDA(dst, b, h) do { _Pragma("unroll") for (int m = 0; m < 4; ++m) _Pragma("unroll") for (int k = 0; k < 2; ++k) dst[m][k] = *(const PG8_LAS bf16x8*)(lds + PG8_SA(b, h) + aoff + m * 2048 + k * 1024); } while (0)
#define PG8_LDB(dst, b, h) do { _Pragma("unroll") for (int n = 0; n < 2; ++n) _Pragma("unroll") for (int k = 0; k < 2; ++k) dst[n][k] = *(const PG8_LAS bf16x8*)(lds + PG8_SB(b, h) + boff + n * 2048 + k * 1024); } while (0)
#define PG8_MMA(ai, bj, At, Bt) do { __builtin_amdgcn_s_setprio(1); _Pragma("unroll") for (int m = 0; m < 4; ++m) _Pragma("unroll") for (int n = 0; n < 2; ++n) _Pragma("unroll") for (int k = 0; k < 2; ++k) \
        acc[ai][bj][m][n] = __builtin_amdgcn_mfma_f32_16x16x32_bf16(Bt[n][k], At[m][k], acc[ai][bj][m][n], 0, 0, 0); __builtin_amdgcn_s_setprio(0); } while (0)
#define PG8_WAIT_V(n) asm volatile("s_waitcnt vmcnt(" #n ")" ::: "memory")
#define PG8_WAIT_L(n) asm volatile("s_waitcnt lgkmcnt(" #n ")" ::: "memory")
#define PG8_BAR __builtin_amdgcn_s_barrier()
#define PG8_SCHED __builtin_amdgcn_sched_barrier(0)
    Unit cur, nxt; int ui = 0;
    if (!S.next(0, cur)) return;
    f32x4 acc[2][2][4][2];
#pragma unroll
    for (int a = 0; a < 2; ++a)
#pragma unroll
        for (int b = 0; b < 2; ++b)
#pragma unroll
            for (int m = 0; m < 4; ++m)
#pragma unroll
                for (int n = 0; n < 2; ++n) acc[a][b][m][n] = (f32x4){0.f, 0.f, 0.f, 0.f};
    bf16x8 At[4][2], B0[2][2], B1[2][2];
    const char* cA = (const char*)g.A + (size_t)cur.pm * tstepA; const char* cB = (const char*)g.Bt + (size_t)cur.pn * tstepB;
    S.a_ready(cur);
    if constexpr (SP2) {
        PG8_STAGE(PG8_SB(0, 0), cB, voffB); PG8_STAGE(PG8_SB(0, 1), cB + hstepB, voffB); PG8_STAGE(PG8_SA(0, 0), cA, voffA); PG8_STAGE(PG8_SA(0, 1), cA + hstepA, voffA);
        if (wr == 1) PG8_BAR;
        PG8_WAIT_V(2); PG8_BAR;
        PG8_STAGE(PG8_SB(1, 0), cB + kstep, voffB); PG8_STAGE(PG8_SA(1, 0), cA + kstep, voffA); PG8_STAGE(PG8_SB(1, 1), cB + hstepB + kstep, voffB);
        PG8_WAIT_V(6); PG8_BAR;
    } else {
        PG8_STAGE(PG8_SB(0, 0), cB, voffB); PG8_STAGE(PG8_SA(0, 0), cA, voffA); PG8_STAGE(PG8_SB(0, 1), cB + hstepB, voffB); PG8_STAGE(PG8_SA(0, 1), cA + hstepA, voffA);
        if (wr == 1) PG8_BAR;
        PG8_WAIT_V(4); PG8_BAR;
        PG8_STAGE(PG8_SB(1, 0), cB + kstep, voffB); PG8_STAGE(PG8_SA(1, 0), cA + kstep, voffA); PG8_STAGE(PG8_SB(1, 1), cB + hstepB + kstep, voffB);
        PG8_WAIT_V(6); PG8_BAR;
    }
    for (;;) {
        const bool has_next = S.next(ui + 1, nxt);
        const char* nA = has_next ? (const char*)g.A + (size_t)nxt.pm * tstepA : cA; const char* nB = has_next ? (const char*)g.Bt + (size_t)nxt.pn * tstepB : cB;
_Pragma("nounroll")
        for (int t = 0; t < nt; t += 2) {
            const bool last = (t == nt - 2);
            const char* a1 = cA + (size_t)(t + 1) * kstep;
            const char* a2 = last ? nA : cA + (size_t)(t + 2) * kstep; const char* b2 = last ? nB : cB + (size_t)(t + 2) * kstep;
            const char* a3 = a2 + kstep; const char* b3 = b2 + kstep;
            if (last && has_next) S.a_ready(nxt);
            if constexpr (SP2) {
            PG8_LDB(B0, 0, 0); PG8_LDB(B1, 0, 1); PG8_SCHED; PG8_LDA(At, 0, 0); PG8_STAGE(PG8_SA(1, 1), a1 + hstepA, voffA);
            PG8_WAIT_V(8); PG8_WAIT_L(0); PG8_BAR; PG8_MMA(0, 0, At, B0); PG8_MMA(0, 1, At, B1); PG8_BAR; PG8_SCHED;
            PG8_LDA(At, 0, 1); PG8_STAGE(PG8_SB(0, 0), b2, voffB); PG8_STAGE(PG8_SB(0, 1), b2 + hstepB, voffB); PG8_STAGE(PG8_SA(0, 0), a2, voffA);
            PG8_WAIT_V(8); PG8_WAIT_L(0); PG8_BAR; PG8_MMA(1, 0, At, B0); PG8_MMA(1, 1, At, B1); PG8_BAR; PG8_SCHED;
            PG8_LDB(B0, 1, 0); PG8_LDB(B1, 1, 1); PG8_SCHED; PG8_LDA(At, 1, 0); PG8_STAGE(PG8_SA(0, 1), a2 + hstepA, voffA);
            PG8_WAIT_V(8); PG8_WAIT_L(0); PG8_BAR; PG8_MMA(0, 0, At, B0); PG8_MMA(0, 1, At, B1); PG8_BAR; PG8_SCHED;
            PG8_LDA(At, 1, 1); PG8_STAGE(PG8_SB(1, 0), b3, voffB); PG8_STAGE(PG8_SB(1, 1), b3 + hstepB, voffB); PG8_STAGE(PG8_SA(1, 0), a3, voffA);
            PG8_WAIT_V(8); PG8_WAIT_L(0); PG8_BAR; PG8_MMA(1, 0, At, B0); PG8_MMA(1, 1, At, B1); PG8_BAR; PG8_SCHED;
            } else {
            PG8_LDB(B0, 0, 0); PG8_SCHED; PG8_LDA(At, 0, 0); PG8_STAGE(PG8_SA(1, 1), a1 + hstepA, voffA);
            PG8_WAIT_L(8); PG8_BAR; PG8_WAIT_L(0); PG8_MMA(0, 0, At, B0); PG8_BAR; PG8_SCHED;
            PG8_LDB(B1, 0, 1); PG8_STAGE(PG8_SB(0, 0), b2, voffB);
            PG8_BAR; PG8_WAIT_L(0); PG8_MMA(0, 1, At, B1); PG8_BAR;
            PG8_LDA(At, 0, 1); PG8_STAGE(PG8_SA(0, 0), a2, voffA);
            PG8_BAR; PG8_WAIT_L(0); PG8_MMA(1, 0, At, B0); PG8_BAR; PG8_SCHED;
            PG8_STAGE(PG8_SB(0, 1), b2 + hstepB, voffB);
            PG8_WAIT_V(6); PG8_BAR; PG8_MMA(1, 1, At, B1); PG8_BAR;
            PG8_LDB(B0, 1, 0); PG8_SCHED; PG8_LDA(At, 1, 0); PG8_STAGE(PG8_SA(0, 1), a2 + hstepA, voffA);
            PG8_WAIT_L(8); PG8_BAR; PG8_WAIT_L(0); PG8_MMA(0, 0, At, B0); PG8_BAR; PG8_SCHED;
            PG8_LDB(B1, 1, 1); PG8_STAGE(PG8_SB(1, 0), b3, voffB);
            PG8_BAR; PG8_WAIT_L(0); PG8_MMA(0, 1, At, B1); PG8_BAR;
            PG8_LDA(At, 1, 1); PG8_STAGE(PG8_SA(1, 0), a3, voffA);
            PG8_BAR; PG8_WAIT_L(0); PG8_MMA(1, 0, At, B0); PG8_BAR; PG8_SCHED;
            PG8_STAGE(PG8_SB(1, 1), b3 + hstepB, voffB);
            PG8_WAIT_V(6); PG8_BAR; PG8_MMA(1, 1, At, B1); PG8_BAR;
            }
        }
        if constexpr (ALIGN_EPI) { if (wr == 0) PG8_BAR; }
        if constexpr (!Epi::AFTER_DRAIN) { E(acc, cur, wr, wc, fr, fq); S.done(cur); }
        if (!has_next) break;
#pragma unroll
        for (int a = 0; a < 2; ++a)
#pragma unroll
            for (int b = 0; b < 2; ++b)
#pragma unroll
                for (int m = 0; m < 4; ++m)
#pragma unroll
                    for (int n = 0; n < 2; ++n) acc[a][b][m][n] = (f32x4){0.f, 0.f, 0.f, 0.f};
        cur = nxt; cA = nA; cB = nB; ++ui;
        if constexpr (ALIGN_EPI) { if (wr == 1) PG8_BAR; }
    }
    PG8_WAIT_V(0);
    if constexpr (!ALIGN_EPI) { if (wr == 0) PG8_BAR; }
    PG8_BAR;
    if constexpr (Epi::AFTER_DRAIN) { E.fused(acc, cur, wr, wc, fr, fq, lds, wid, lane); S.done(cur); }
#undef PG8_SA
#undef PG8_SB
#undef PG8_STAGE
#undef PG8_LDA
#undef PG8_LDB
#undef PG8_MMA
#undef PG8_WAIT_V
#undef PG8_WAIT_L
#undef PG8_BAR
#undef PG8_SCHED
}
}

#define PG8_ALIGN true
#include <hip/hip_bf16.h>
#include <cmath>
namespace attn_body {
using bf16=__hip_bfloat16;
using bf16x8=__attribute__((ext_vector_type(8)))short;
using s16x4=__attribute__((ext_vector_type(4)))short;
using f32x16=__attribute__((ext_vector_type(16)))float;
using u32x4=__attribute__((ext_vector_type(4)))unsigned;
using f32x4_t=__attribute__((ext_vector_type(4)))float;
constexpr int BATCH=8,NHEAD=16,SEQ=4096,D=64,DM=NHEAD*D;
constexpr int NW=8,QBLK=32,QB=QBLK*NW,KVBLK=64,NQB=SEQ/QB;
constexpr int ATTN_PITCH=DM, ATTN_UNIT_ROWS=QB;
__device__ __forceinline__ int crow(int r,int hi){return (r&3)+8*(r>>2)+4*hi;}
#define SBAR() __builtin_amdgcn_sched_barrier(0)
__device__ __forceinline__ void cmask(f32x16&p0,f32x16&p1,int jb,int qrel,int hi){
  const float NEG=-INFINITY; int kb=64*jb+4*hi;
  #pragma unroll
  for(int r=0;r<16;++r){int kv=kb+(r&3)+8*(r>>2); if(kv>qrel)p0[r]=NEG; if(kv+32>qrel)p1[r]=NEG;}
}

constexpr int NSLOT=3, SLOTB=8192;
constexpr int LDS_K=0, LDS_V=NSLOT*SLOTB, LDS_WS=2*NSLOT*SLOTB, LDS_OST=LDS_WS+NW*64*4, LDS_CKT=LDS_OST+NW*4096, LDS_BYTES=LDS_CKT+(SEQ+64)*4;
constexpr float SKIP_THR=24.f;
constexpr float C2=0.125f*1.4426950408889634f;
__device__ __forceinline__ void glds16(const void*gsrc,unsigned lds_dst){unsigned keep;
  asm volatile("s_mov_b32 %0, m0\n\ts_mov_b32 m0, %2\n\ts_nop 0\n\tglobal_load_lds_dwordx4 %1, off\n\ts_mov_b32 m0, %0":"=&s"(keep):"v"(gsrc),"s"(lds_dst):"memory");}
__device__ __forceinline__ float max3f(float a,float b,float c){float r;asm("v_max3_f32 %0, %1, %2, %3":"=v"(r):"v"(a),"v"(b),"v"(c));return r;}
__device__ __forceinline__ float max2f(float a,float b){float r;asm("v_max_f32_e32 %0, %1, %2":"=v"(r):"v"(a),"v"(b));return r;}
__device__ __forceinline__ float fadd_s(float a,float b){float r;asm("v_add_f32_e32 %0, %1, %2":"=v"(r):"v"(a),"v"(b));return r;}
__device__ __forceinline__ float fsub_s(float a,float b){float r;asm("v_sub_f32_e32 %0, %1, %2":"=v"(r):"v"(a),"v"(b));return r;}
typedef float f32x2_t __attribute__((ext_vector_type(2))); typedef __bf16 bf16x2_t __attribute__((ext_vector_type(2)));
__device__ __forceinline__ unsigned cvtpk_s(float lo,float hi){f32x2_t v={lo,hi};bf16x2_t b=__builtin_convertvector(v,bf16x2_t);return __builtin_bit_cast(unsigned,b);}
#define WAIT_BAR(N) asm volatile("s_waitcnt vmcnt(" #N ") lgkmcnt(0)\n\ts_barrier":::"memory")

__device__ __forceinline__ void qkt(f32x16&p0,f32x16&p1,const char*Kslot,const bf16x8*qr,int r32,int hi){
  const char*kb=Kslot+hi*1024+r32*16;
  #pragma unroll
  for(int d0=0;d0<4;++d0){
    const bf16x8 b0=*reinterpret_cast<const bf16x8*>(kb+d0*2048);
    const bf16x8 b1=*reinterpret_cast<const bf16x8*>(kb+d0*2048+512);
    {p0=__builtin_amdgcn_mfma_f32_32x32x16_bf16(b0,qr[d0],p0,0,0,0);p1=__builtin_amdgcn_mfma_f32_32x32x16_bf16(b1,qr[d0],p1,0,0,0);}}
}
typedef __attribute__((address_space(3))) const char* lds_cptr;
typedef short v4i16_t __attribute__((ext_vector_type(4)));
__device__ __forceinline__ void kload8(bf16x8*kf,lds_cptr kp){
  kf[0]=*(const __attribute__((address_space(3))) bf16x8*)(kp);      kf[1]=*(const __attribute__((address_space(3))) bf16x8*)(kp+512);
  kf[2]=*(const __attribute__((address_space(3))) bf16x8*)(kp+2048); kf[3]=*(const __attribute__((address_space(3))) bf16x8*)(kp+2560);
  kf[4]=*(const __attribute__((address_space(3))) bf16x8*)(kp+4096); kf[5]=*(const __attribute__((address_space(3))) bf16x8*)(kp+4608);
  kf[6]=*(const __attribute__((address_space(3))) bf16x8*)(kp+6144); kf[7]=*(const __attribute__((address_space(3))) bf16x8*)(kp+6656);
}
__device__ __forceinline__ void kload2(bf16x8*kf,lds_cptr kp,int j){ kf[2*j]=*(const __attribute__((address_space(3))) bf16x8*)(kp+j*2048); kf[2*j+1]=*(const __attribute__((address_space(3))) bf16x8*)(kp+j*2048+512); }
__device__ __forceinline__ s16x4 vtr(lds_cptr p){ return __builtin_bit_cast(s16x4,__builtin_amdgcn_ds_read_tr16_b64_v4i16((__attribute__((address_space(3))) v4i16_t*)p)); }
__device__ __forceinline__ float rowmax(const f32x16&p0,const f32x16&p1){
  float a=max3f(p0[0],p0[1],p1[0]),b=max3f(p0[2],p0[3],p1[1]);a=max3f(a,p1[2],p1[3]);
  #pragma unroll
  for(int r=4;r<16;r+=4){a=max3f(a,p0[r],p0[r+1]);b=max3f(b,p0[r+2],p0[r+3]);a=max3f(a,p1[r],p1[r+1]);b=max3f(b,p1[r+2],p1[r+3]);}
  const float m=max2f(a,b);
  auto rr=__builtin_amdgcn_permlane32_swap(__float_as_uint(m),__float_as_uint(m),false,false);
  return max2f(__uint_as_float(rr[0]),__uint_as_float(rr[1]));
}
__device__ __forceinline__ void pv(f32x16*o,int vb,bf16x8 pa0,bf16x8 pa1,bf16x8 pa2,bf16x8 pa3){
  #pragma unroll
  for(int d0=0;d0<2;++d0){s16x4 lo[4],hi[4];
    #pragma unroll
    for(int ks=0;ks<4;++ks){
      asm volatile("ds_read_b64_tr_b16 %0,%1 offset:%c2":"=&v"(lo[ks]):"v"(vb),"i"(d0*4096+ks*1024):"memory");
      asm volatile("ds_read_b64_tr_b16 %0,%1 offset:%c2":"=&v"(hi[ks]):"v"(vb),"i"(d0*4096+ks*1024+512):"memory");}
    asm volatile("s_waitcnt lgkmcnt(0)":::"memory");SBAR();
    #define PK(k) (bf16x8){lo[k][0],lo[k][1],lo[k][2],lo[k][3],hi[k][0],hi[k][1],hi[k][2],hi[k][3]}
    o[d0]=__builtin_amdgcn_mfma_f32_32x32x16_bf16(pa0,PK(0),o[d0],0,0,0);
    o[d0]=__builtin_amdgcn_mfma_f32_32x32x16_bf16(pa1,PK(1),o[d0],0,0,0);
    o[d0]=__builtin_amdgcn_mfma_f32_32x32x16_bf16(pa2,PK(2),o[d0],0,0,0);
    o[d0]=__builtin_amdgcn_mfma_f32_32x32x16_bf16(pa3,PK(3),o[d0],0,0,0);
    #undef PK
  }
}

#ifndef ATTN_STORE16
#define ATTN_STORE16(p,v) (*(u32x4*)(p)=(v))
#endif
template<int THRL> __device__ __forceinline__ void attn_unit(int b,int h,int qb,const bf16*Q,const bf16*__restrict__ K,const bf16*__restrict__ V,const bf16*__restrict__ GT,const float*__restrict__ CK2,const unsigned*__restrict__ QN2,const unsigned*__restrict__ KN2,const unsigned*__restrict__ DG2,bf16*O,char*shm){
  int tid_=threadIdx.x; asm volatile("":"+v"(tid_)); const int tid=tid_,lane=tid&63,r32=lane&31,hi=lane>>5; const int wid=__builtin_amdgcn_readfirstlane(tid>>6);
  const long rowbase=(long)b*SEQ; const int q0=qb*QB;
  const bf16*Qw=Q+(rowbase+q0+wid*QBLK)*DM+h*D;
  const float*ckg=CK2+((long)(b*NHEAD+h))*SEQ; const int NTF=(q0+QB)/KVBLK; int tskip;
  { const float qn_=sqrtf(__uint_as_float(QN2[(b*NHEAD+h)*NQB+qb])),kn_=sqrtf(__uint_as_float(KN2[b*NHEAD+h])); const float A_=qn_*kn_+__uint_as_float(DG2[(b*NHEAD+h)*NQB+qb])+ckg[q0]+SKIP_THR;
    const float ce_=(lane<NTF)?ckg[64*lane+63]:0.f; const bool pr_=(lane<NTF)&&(A_-ce_<0.f);
    tskip=(int)__popcll(__ballot(pr_)); tskip&=~1; if(tskip>NTF-4)tskip=NTF-4; tskip=__builtin_amdgcn_readfirstlane(tskip); }
  const bf16*Kh=K+(rowbase+(long)tskip*KVBLK)*DM+h*D,*Vh=V+(rowbase+(long)tskip*KVBLK)*DM+h*D;
  const unsigned lds0=(unsigned)(uintptr_t)shm; const lds_cptr shm3=(lds_cptr)shm;
  float*wsf=(float*)(shm+LDS_WS)+wid*64;
  const bf16*ksrc=Kh+(long)lane*DM+wid*8;
  const bf16*vsrc=Vh+(long)(16*(wid&3)+(lane>>2))*DM+(wid>>2)*32+(lane&3)*8;
  const unsigned kdst=lds0+LDS_K+wid*1024, vdst=lds0+LDS_V+wid*1024;
  #define DMA_K(t,slot) glds16(ksrc+(long)(t)*KVBLK*DM,(unsigned)__builtin_amdgcn_readfirstlane(kdst+(slot)))
  #define DMA_V(t,slot) glds16(vsrc+(long)(t)*KVBLK*DM,(unsigned)__builtin_amdgcn_readfirstlane(vdst+(slot)))
  const int vb0=(int)(lds0+LDS_V)+((lane>>4)&1)*32+(lane&3)*8+(4*hi+((lane&15)>>2))*64;
  const char*Kbase=shm+LDS_K; bf16x8 kf[8];
  const lds_cptr kp0=shm3+LDS_K+hi*1024+r32*16; const lds_cptr vp0=shm3+LDS_V+((lane>>4)&1)*32+(lane&3)*8+(4*hi+((lane&15)>>2))*64;
  const int NT=NTF-tskip;
  typedef __attribute__((address_space(3))) float* lds_fptr;
  const lds_fptr ckt=(lds_fptr)(shm3+LDS_CKT);
  { const int n_=q0+QB-64*tskip; const float*cks_=ckg+64*tskip;
    for(int i_=tid*4;i_<n_;i_+=2048){ const f32x4_t v_=*(const __attribute__((address_space(1))) f32x4_t*)(cks_+i_); *(__attribute__((address_space(3))) f32x4_t*)(ckt+i_)=v_; } }
  float cq2=CK2[((long)(b*NHEAD+h))*SEQ+q0+wid*QBLK+r32];
  float base=cq2;
  #define BIAS_INIT(C0,C1,t) do{ const lds_fptr cp_=ckt+64*(t)+4*hi; \
    _Pragma("unroll") for(int j_=0;j_<4;++j_){ const f32x4_t a_=*(const __attribute__((address_space(3))) f32x4_t*)(cp_+8*j_); const f32x4_t b_=*(const __attribute__((address_space(3))) f32x4_t*)(cp_+32+8*j_); \
      C0[4*j_]=base-a_[0];C0[4*j_+1]=base-a_[1];C0[4*j_+2]=base-a_[2];C0[4*j_+3]=base-a_[3]; C1[4*j_]=base-b_[0];C1[4*j_+1]=base-b_[1];C1[4*j_+2]=base-b_[2];C1[4*j_+3]=base-b_[3]; } }while(0)
  DMA_K(0,0);DMA_V(0,0);DMA_K(1,SLOTB);
  bf16x8 qr[4];
  #pragma unroll
  for(int d0=0;d0<4;++d0)qr[d0]=*reinterpret_cast<const bf16x8*>(&Qw[(long)r32*DM+d0*16+hi*8]);
  float mhat=0.f,l_reg=0.f;f32x16 o[2];o[0]=f32x16{};o[1]=f32x16{};
  const int qrel=wid*QBLK+r32;
  #define CMASK(P0,P1,t) do{int jb_=(t)-(NT-4); if(jb_>=0)cmask(P0,P1,jb_,qrel,hi);}while(0)
  bool resc=false;
  #define START(P0,P1) do{ const float rm=rowmax(P0,P1); resc=false; \
    { const float dl=rm; mhat=fadd_s(mhat,dl); \
      _Pragma("unroll") for(int r=0;r<16;++r){P0[r]=fsub_s(P0[r],dl);P1[r]=fsub_s(P1[r],dl);} \
      base=cq2-mhat; } \
    _Pragma("unroll") for(int r=0;r<16;++r)P0[r]=__builtin_amdgcn_exp2f(P0[r]); }while(0)
  #define RESC() do{ if(resc){ asm volatile("s_waitcnt lgkmcnt(0)":::"memory"); \
      _Pragma("unroll") for(int d_=0;d_<2;++d_) _Pragma("unroll") for(int r=0;r<16;++r)o[d_][r]*=wsf[crow(r,hi)]; } }while(0)
  f32x16 pA0,pA1,pB0,pB1;
  int sl_prev=0,sl_cur=0,sl_next=SLOTB;
  #define ROT() do{sl_prev=sl_cur;sl_cur=sl_next;sl_next=(sl_next==(NSLOT-1)*SLOTB)?0:sl_next+SLOTB;}while(0)
  DMA_K(2,2*SLOTB);
  WAIT_BAR(3);
  BIAS_INIT(pA0,pA1,0); qkt(pA0,pA1,Kbase,qr,r32,hi);asm volatile("s_nop 15\n\ts_nop 7":"+v"(pA0),"+v"(pA1));CMASK(pA0,pA1,0);
  START(pA0,pA1);
  _Pragma("unroll") for(int r=0;r<16;++r)pA1[r]=__builtin_amdgcn_exp2f(pA1[r]);
  WAIT_BAR(0);
  DMA_K(3,0);DMA_V(1,SLOTB);
  ROT();
  kload8(kf,kp0+sl_cur);
  WAIT_BAR(2);
  s16x4 vlo[8],vhi[8]; u32x4 pw0,pw1,pw2,pw3;
  #define PKW(P,B) cvtpk_s(P[B],P[B+1])
  #define PAF(k) __builtin_bit_cast(bf16x8,pw##k)
  #define VFR(i) (bf16x8){vlo[i][0],vlo[i][1],vlo[i][2],vlo[i][3],vhi[i][0],vhi[i][1],vhi[i][2],vhi[i][3]}
  #define PIN(x) asm volatile("":"+v"(x))
  #define MX3(a,b,c) __builtin_fmaxf(__builtin_fmaxf((a),(b)),(c))
  #define GAPA(MF,A0,A1,A2,A3,W0,W1,PW) do{ MF; sacc+=A0; sacc+=A1; sacc+=A2; sacc+=A3; PIN(sacc); W0; W1; PIN(PW); SBAR(); }while(0)
  #define EX(v) __builtin_amdgcn_exp2f(v)
  #define GAPB(MF,X,B) do{ MF; X[B]=EX(X[B]); X[B+1]=EX(X[B+1]); X[B+2]=EX(X[B+2]); X[B+3]=EX(X[B+3]); PIN(X); SBAR(); }while(0)
  #define VRD(i) do{ vlo[i]=vtr(vp_+(((i)>>2)*4096+((i)&3)*1024)); vhi[i]=vtr(vp_+(((i)>>2)*4096+((i)&3)*1024+512)); }while(0)
  #define KRD(G,j) do{ if(G){ kload2(kf,kp0+sl_next,j); SBAR(); } }while(0)
  #define STEP(C0,C1,P0,P1,t,GK,GV,GL) do{ SBAR(); BIAS_INIT(C0,C1,t); SBAR(); \
    const lds_cptr vp_=vp0+sl_prev; \
    VRD(0); SBAR(); float sacc=(P0[0]+P0[1]); \
    GAPA(C0=__builtin_amdgcn_mfma_f32_32x32x16_bf16(kf[0],qr[0],C0,0,0,0), P0[2],P0[3],P0[4],P0[5],     pw0[0]=PKW(P0,0), pw0[1]=PKW(P0,2), pw0); \
    VRD(4); SBAR(); GAPA(C1=__builtin_amdgcn_mfma_f32_32x32x16_bf16(kf[1],qr[0],C1,0,0,0), P0[6],P0[7],P0[8],P0[9],     pw0[2]=PKW(P0,4), pw0[3]=PKW(P0,6), pw0); \
    VRD(1); SBAR(); GAPA(C0=__builtin_amdgcn_mfma_f32_32x32x16_bf16(kf[2],qr[1],C0,0,0,0),   P0[10],P0[11],P0[12],P0[13], pw1[0]=PKW(P0,8), pw1[1]=PKW(P0,10), pw1); \
    VRD(5); SBAR(); GAPA(C1=__builtin_amdgcn_mfma_f32_32x32x16_bf16(kf[3],qr[1],C1,0,0,0),   P0[14],P0[15],P1[0],P1[1],   pw1[2]=PKW(P0,12),pw1[3]=PKW(P0,14), pw1); \
    VRD(2); SBAR(); GAPA(C0=__builtin_amdgcn_mfma_f32_32x32x16_bf16(kf[4],qr[2],C0,0,0,0),   P1[2],P1[3],P1[4],P1[5],     pw2[0]=PKW(P1,0), pw2[1]=PKW(P1,2), pw2); \
    VRD(6); SBAR(); GAPA(C1=__builtin_amdgcn_mfma_f32_32x32x16_bf16(kf[5],qr[2],C1,0,0,0),   P1[6],P1[7],P1[8],P1[9],     pw2[2]=PKW(P1,4), pw2[3]=PKW(P1,6), pw2); \
    VRD(3); SBAR(); GAPA(C0=__builtin_amdgcn_mfma_f32_32x32x16_bf16(kf[6],qr[3],C0,0,0,0),   P1[10],P1[11],P1[12],P1[13], pw3[0]=PKW(P1,8), pw3[1]=PKW(P1,10), pw3); \
    VRD(7); SBAR(); GAPA(C1=__builtin_amdgcn_mfma_f32_32x32x16_bf16(kf[7],qr[3],C1,0,0,0),   P1[14],P1[15],0.f,0.f,       pw3[2]=PKW(P1,12),pw3[3]=PKW(P1,14), pw3); \
    l_reg+=sacc; \
    if(GK){DMA_K((t)+3,sl_cur);} if(GV){DMA_V((t)+1,sl_next);} \
    CMASK(C0,C1,t); \
    { float a=MX3(C0[0],C0[1],C1[0]),b=MX3(C0[2],C0[3],C1[1]); a=MX3(a,C1[2],C1[3]); \
      _Pragma("unroll") for(int r=4;r<16;r+=4){a=MX3(a,C0[r],C0[r+1]);b=MX3(b,C0[r+2],C0[r+3]);a=MX3(a,C1[r],C1[r+1]);b=MX3(b,C1[r+2],C1[r+3]);} \
      float rm=__builtin_fmaxf(a,b); { auto rr=__builtin_amdgcn_permlane32_swap(__float_as_uint(rm),__float_as_uint(rm),false,false); rm=__builtin_fmaxf(__uint_as_float(rr[0]),__uint_as_float(rr[1])); } \
      resc=false; \
      if(__builtin_expect(__any(rm>(float)THRL),0)){ const float dl=__builtin_fmaxf(rm,0.f); mhat+=dl; \
        _Pragma("unroll") for(int r=0;r<16;++r){C0[r]-=dl;C1[r]-=dl;} \
        base=cq2-mhat; \
        const float f=__builtin_amdgcn_exp2f(-dl); l_reg*=f; if(hi==0)wsf[r32]=f; resc=true; } } \
    SBAR(); \
    GAPB(o[0]=__builtin_amdgcn_mfma_f32_32x32x16_bf16(PAF(0),VFR(0),o[0],0,0,0), C0,0); \
    GAPB(o[1]=__builtin_amdgcn_mfma_f32_32x32x16_bf16(PAF(0),VFR(4),o[1],0,0,0), C0,4); \
    KRD(GL,0); GAPB(o[0]=__builtin_amdgcn_mfma_f32_32x32x16_bf16(PAF(1),VFR(1),o[0],0,0,0), C0,8); \
    KRD(GL,1); GAPB(o[1]=__builtin_amdgcn_mfma_f32_32x32x16_bf16(PAF(1),VFR(5),o[1],0,0,0), C0,12); \
    KRD(GL,2); GAPB(o[0]=__builtin_amdgcn_mfma_f32_32x32x16_bf16(PAF(2),VFR(2),o[0],0,0,0), C1,0); \
    KRD(GL,3); GAPB(o[1]=__builtin_amdgcn_mfma_f32_32x32x16_bf16(PAF(2),VFR(6),o[1],0,0,0), C1,4); \
    GAPB(o[0]=__builtin_amdgcn_mfma_f32_32x32x16_bf16(PAF(3),VFR(3),o[0],0,0,0), C1,8); \
    GAPB(o[1]=__builtin_amdgcn_mfma_f32_32x32x16_bf16(PAF(3),VFR(7),o[1],0,0,0), C1,12); \
    }while(0)
  int t=1;
  #undef CMASK
  #define CMASK(P0,P1,t) do{}while(0)
  for(;t+5<NT;t+=2){
    STEP(pB0,pB1,pA0,pA1,t,true,true,true);     WAIT_BAR(2); RESC(); ROT();
    STEP(pA0,pA1,pB0,pB1,t+1,true,true,true);   WAIT_BAR(2); RESC(); ROT();
  }
  #undef CMASK
  #define CMASK(P0,P1,t) do{int jb_=(t)-(NT-4); if(jb_>=0)cmask(P0,P1,jb_,qrel,hi);}while(0)
  #define ENDW(tt) do{ if((tt)+3<NT){WAIT_BAR(2);} else if((tt)+2<NT){WAIT_BAR(1);} else {WAIT_BAR(0);} }while(0)
  for(;t+1<NT;t+=2){
    STEP(pB0,pB1,pA0,pA1,t,(t+3<NT),(t+1<NT),(t+1<NT));       ENDW(t);   RESC(); ROT();
    STEP(pA0,pA1,pB0,pB1,t+1,(t+4<NT),(t+2<NT),(t+2<NT));     ENDW(t+1); RESC(); ROT();
  }
  STEP(pB0,pB1,pA0,pA1,NT-1,false,false,false); RESC();
  { float sacc=pB0[0]+pB0[1]; _Pragma("unroll") for(int r=2;r<16;++r)sacc+=pB0[r]; _Pragma("unroll") for(int r=0;r<16;++r)sacc+=pB1[r]; l_reg+=sacc;
    pw0=(u32x4){PKW(pB0,0),PKW(pB0,2),PKW(pB0,4),PKW(pB0,6)};pw1=(u32x4){PKW(pB0,8),PKW(pB0,10),PKW(pB0,12),PKW(pB0,14)};pw2=(u32x4){PKW(pB1,0),PKW(pB1,2),PKW(pB1,4),PKW(pB1,6)};pw3=(u32x4){PKW(pB1,8),PKW(pB1,10),PKW(pB1,12),PKW(pB1,14)};
    SBAR(); pv(o,vb0+sl_cur,PAF(0),PAF(1),PAF(2),PAF(3)); }
  #undef PKW
  #undef PAF
  #undef VFR
  #undef PIN
  #undef MX3
  #undef GAPA
  #undef GAPB
  #undef EX
  #undef VRD
  #undef KRD
  #undef STEP
  #undef ENDW
  {auto rr=__builtin_amdgcn_permlane32_swap(__float_as_uint(l_reg),__float_as_uint(l_reg),false,false);l_reg=__uint_as_float(rr[0])+__uint_as_float(rr[1]);}
  if(hi==0)wsf[32+r32]=l_reg;asm volatile("s_waitcnt lgkmcnt(0)":::"memory");
  float rli[16];
  #pragma unroll
  for(int r=0;r<16;++r)rli[r]=__builtin_amdgcn_rcpf(wsf[32+crow(r,hi)]);
  bf16*Ow=O+(rowbase+q0+wid*QBLK)*DM+h*D; const bf16*Gw=GT+(rowbase+q0+wid*QBLK)*DM+h*D;
  u32x4 ggs[4];
  _Pragma("unroll") for(int i=0;i<4;++i){const int row=i*8+(lane>>3),ch=lane&7; ggs[i]=*(const u32x4*)(Gw+(long)row*DM+ch*8);}
  { bf16*stg=(bf16*)(shm+LDS_OST)+wid*2048;
    #pragma unroll
    for(int r=0;r<16;++r){const int orow=crow(r,hi);
      #pragma unroll
      for(int d0=0;d0<2;++d0)stg[orow*64+d0*32+r32]=__float2bfloat16(o[d0][r]*rli[r]);}
    asm volatile("s_waitcnt lgkmcnt(0)":::"memory");
    #pragma unroll
    for(int i=0;i<4;++i){const int row=i*8+(lane>>3),ch=lane&7; u32x4 v=*(const u32x4*)(stg+row*64+ch*8); const u32x4 gg=ggs[i];
      #pragma unroll
      for(int e=0;e<4;++e){ const float olo=__uint_as_float(v[e]<<16),ohi=__uint_as_float(v[e]&0xffff0000u),glo=__uint_as_float(gg[e]<<16),ghi=__uint_as_float(gg[e]&0xffff0000u);
        const float slo=__builtin_amdgcn_rcpf(1.0f+__builtin_amdgcn_exp2f(-1.4426950408889634f*glo)),shi=__builtin_amdgcn_rcpf(1.0f+__builtin_amdgcn_exp2f(-1.4426950408889634f*ghi));
        v[e]=cvtpk_s(olo*slo,ohi*shi); }
      ATTN_STORE16(Ow+(long)row*DM+ch*8,v);} }
  asm volatile("s_waitcnt lgkmcnt(0)\n\ts_barrier":::"memory");
  #undef BIAS_INIT
  #undef DMA_K
  #undef DMA_V
  #undef CMASK
  #undef START
  #undef RESC
  #undef ROT
}
constexpr int ATTN_LDS_BYTES=LDS_BYTES;
struct AttnTensors { const bf16* Q; const bf16* K; const bf16* V; const bf16* G; const float* CK2; const unsigned* QN2; const unsigned* KN2; const unsigned* DG2; bf16* O; };
struct AttnUnit { int bh; int qb; };
struct StaticOrder {
  int vcu;
  __device__ __forceinline__ explicit StaticOrder(int grid,int block):vcu((block%8)*(grid/8)+block/8){}
  __device__ __forceinline__ bool next(int i,AttnUnit&u)const{ if(i>=8)return false; const int s=2*(i>>1)+(vcu&1); u.bh=vcu>>1; u.qb=(i&1)?s:15-s; return true; }
  __device__ __forceinline__ void a_ready(const AttnUnit&)const{}
  __device__ __forceinline__ void done(const AttnUnit&)const{}
};
struct QueueOrder {
  unsigned* ctr; volatile __attribute__((address_space(3))) unsigned* slot;
  __device__ __forceinline__ bool next(int,AttnUnit&u)const{
    if(threadIdx.x==0){ const unsigned v_=__hip_atomic_fetch_add(ctr,1u,__ATOMIC_RELAXED,__HIP_MEMORY_SCOPE_AGENT); *slot=v_; }
    asm volatile("s_waitcnt vmcnt(0) lgkmcnt(0)\n\ts_barrier":::"memory");
    const unsigned v=(unsigned)__builtin_amdgcn_readfirstlane(*slot);
    if(v>=(unsigned)(BATCH*NHEAD*NQB))return false; u.qb=NQB-1-(int)(v>>7); u.bh=(int)(v&127u); return true; }
  __device__ __forceinline__ void a_ready(const AttnUnit&)const{}
  __device__ __forceinline__ void done(const AttnUnit&)const{}
};
template<class Sched,int THRL=12> __device__ __forceinline__ void attn_phase(char*lds,const AttnTensors&T,const Sched&S){
  AttnUnit u;
  for(int i=0;S.next(i,u);++i){ S.a_ready(u); attn_unit<THRL>(u.bh/NHEAD,u.bh%NHEAD,u.qb,T.Q,T.K,T.V,T.G,T.CK2,T.QN2,T.KN2,T.DG2,T.O,lds); S.done(u); }
}
#undef SBAR
#undef WAIT_BAR
}
constexpr int NWAVES = 8;
#ifndef WGM_MLP1
#define WGM_MLP1 4
#endif
#ifndef WGM_MLP2
#define WGM_MLP2 4
#endif
#ifndef WGM_PROJ
#define WGM_PROJ 4
#endif
#ifndef WGM_GLU
#define WGM_GLU 4
#endif
#ifndef WGM_WO
#define WGM_WO 4
#endif
#ifndef NSUB
#define NSUB 8
#endif
constexpr int NB = 8, T = 4096, D = 1024, H = 16, HD = 64, FF = 4096, DEPTH = 4;
constexpr int M = NB * T;
constexpr int NPROJ = 4096;
constexpr int NPROJ_REAL = 4 * D + H;
constexpr float RMS_EPS = 1e-6f;
constexpr int S5G = 64, S5P = 64, S5H = 16, TC = 16, NSC = M / TC;
constexpr int S5KA = 384;

constexpr size_t MiB = 1u << 20;
constexpr size_t WS_CTL = 0, CTL_ZERO_BYTES = 1 * MiB;
constexpr size_t WS_WGLU = 1 * MiB;
constexpr size_t WS_WIN = 9 * MiB;
constexpr size_t WS_WOUT = 26 * MiB;
constexpr size_t WS_W1 = 30 * MiB;
constexpr size_t WS_W2 = 62 * MiB;
constexpr size_t WS_S5BM = 94 * MiB;
constexpr size_t WS_S5BS = 118 * MiB;
constexpr size_t WS_H16 = 126 * MiB;
constexpr size_t WS_XN = 190 * MiB;
#define WS_LF_OF(jf) (WS_S5BS + (size_t)(jf) * 4 * MiB)
constexpr size_t WS_CK2 = WS_XN + 2 * MiB;
constexpr size_t WS_BIG = 254 * MiB;
constexpr size_t WS_Q = WS_BIG, WS_K = WS_BIG + 64 * MiB, WS_V = WS_BIG + 128 * MiB, WS_GATE = WS_BIG + 192 * MiB;
constexpr size_t WS_AS5 = WS_BIG, WS_SL = WS_BIG + 96 * MiB, WS_G = WS_BIG + 160 * MiB;
constexpr size_t WS_END = 510 * MiB;
static_assert((size_t)64 * 2048 * 384 * 2 == 96 * MiB && (size_t)M * FF * 2 == 256 * MiB, "map");
constexpr int CW_WF = 163840;
constexpr int CW_ROWINV = 131072;
constexpr int CW_BAR = 4096;
constexpr int CW_QN2 = 32768, CW_KN2 = 40960, CW_QCTR = 45056, CW_DG2 = 49152;

constexpr int RING_OFF = 0, RING_BYTES = 131072;
constexpr int LDSCTL_OFF = RING_BYTES, MISC_OFF = LDSCTL_OFF + 320;
constexpr int LDS_BYTES = 147456;
static_assert(MISC_OFF + 128 <= LDS_BYTES, "LDS map");

struct Args { const float* in[16]; float* out; unsigned char* ws; };
#define GAS __attribute__((address_space(1)))
#define LAS __attribute__((address_space(3)))
typedef unsigned short bf16;
typedef unsigned v4u __attribute__((ext_vector_type(4)));
typedef float f32x4 __attribute__((ext_vector_type(4)));
typedef short bf16x8 __attribute__((ext_vector_type(8)));
typedef GAS unsigned gu32;
typedef GAS unsigned long long gu64;
#define RLX_AGENT __ATOMIC_RELAXED, __HIP_MEMORY_SCOPE_AGENT
#define LDS_WAIT() asm volatile("s_waitcnt lgkmcnt(0)" ::: "memory")
#define VM_WAIT() asm volatile("s_waitcnt vmcnt(0)" ::: "memory")
__device__ __forceinline__ unsigned long long rt() { return __builtin_amdgcn_s_memrealtime(); }
__device__ __forceinline__ unsigned f2bf(float f) { unsigned u = __builtin_bit_cast(unsigned, f); return (u + 0x7fffu + ((u >> 16) & 1u)) >> 16; }
__device__ __forceinline__ unsigned pk2(float lo, float hi) { return f2bf(lo) | (f2bf(hi) << 16); }

#define XB_TMO      128
#define XB_XCNT(j)  (256  + 64 * (j))
#define XB_XSUB(j)  (1280 + 64 * (j))
#define XB_XGEN(j)  (2304 + 64 * (j))
#define XB_TOP      3328
#define XB_TOPGEN   3392
#define XCD_BAR_WORDS 3456
#define XB_SPIN_CAP (1u << 18)

__device__ __forceinline__ unsigned xb_ld(unsigned* p)              { return __hip_atomic_load(p, __ATOMIC_RELAXED, __HIP_MEMORY_SCOPE_AGENT); }
__device__ __forceinline__ unsigned xb_add(unsigned* p, unsigned v) { return __hip_atomic_fetch_add(p, v, __ATOMIC_RELAXED, __HIP_MEMORY_SCOPE_AGENT); }
__device__ __forceinline__ unsigned xb_xcc_id() { return (unsigned)__builtin_amdgcn_s_getreg((3 << 11) | 20) & 0xFu; }
#define XB_SPIN(cond, bar) do { unsigned _sp = 0; while (cond) { __builtin_amdgcn_s_sleep(1); \
    if ((++_sp & 255u) == 0u) { if (xb_ld(&(bar)[XB_TMO])) break; if (_sp > XB_SPIN_CAP) { atomicAdd(&(bar)[XB_TMO], 1u); break; } } } } while (0)

struct XcdBarrier {
    unsigned* bar; unsigned x;
    volatile LAS unsigned* st;
};

__device__ __forceinline__ XcdBarrier xcd_barrier_post(unsigned* bar, volatile LAS unsigned* st) {
    XcdBarrier b; b.bar = bar; b.x = xb_xcc_id(); b.st = st;
    if (threadIdx.x == 0) (void)xb_add(&bar[XB_XCNT(b.x)], 1u);
    return b;
}
__device__ __forceinline__ void xcd_barrier_complete(unsigned* bar, unsigned x, unsigned& nloc, unsigned& nx) {
    const unsigned G = gridDim.x * gridDim.y * gridDim.z;
    unsigned sum, cnt, mine, sp = 0u;
    for (;;) {
        sum = 0u; cnt = 0u; mine = 0u;
#pragma unroll
        for (unsigned j = 0; j < 16; ++j) { const unsigned c = xb_ld(&bar[XB_XCNT(j)]); sum += c; cnt += (c > 0u) ? 1u : 0u; mine = (j == x) ? c : mine; }
        if (sum == G) break;
        __builtin_amdgcn_s_sleep(1);
        if ((++sp & 255u) == 0u) { if (xb_ld(&bar[XB_TMO])) break; if (sp > XB_SPIN_CAP) { atomicAdd(&bar[XB_TMO], 1u); break; } }
    }
    nloc = mine > 0u ? mine : 1u; nx = cnt > 0u ? cnt : 1u;
}

__device__ __forceinline__ void xcd_barrier(const XcdBarrier& b) {
    asm volatile("s_waitcnt vmcnt(0)" ::: "memory");
    __syncthreads();
    if (threadIdx.x == 0) {
        unsigned* bar = b.bar;
        __builtin_amdgcn_s_waitcnt(0);
        unsigned nloc = b.st[0], nx = b.st[1];
        if (nloc == 0u) { xcd_barrier_complete(bar, b.x, nloc, nx); b.st[0] = nloc; b.st[1] = nx; }
        const unsigned old = xb_add(&bar[XB_XSUB(b.x)], 1u);
        const unsigned gen = old / nloc;
        if (old + 1u == (gen + 1u) * nloc) {
            __builtin_amdgcn_fence(__ATOMIC_RELEASE, "agent");
            asm volatile("s_waitcnt vmcnt(0)" ::: "memory");
            const unsigned og = xb_add(&bar[XB_TOP], 1u);
            const unsigned tg = og / nx;
            if (og + 1u == (tg + 1u) * nx) xb_add(&bar[XB_TOPGEN], 1u);
            else XB_SPIN(xb_ld(&bar[XB_TOPGEN]) == tg, bar);
            __builtin_amdgcn_fence(__ATOMIC_ACQUIRE, "agent");
            xb_add(&bar[XB_XGEN(b.x)], 1u);
            asm volatile("s_waitcnt vmcnt(0)" ::: "memory");
        } else {
            XB_SPIN(xb_ld(&bar[XB_XGEN(b.x)]) == gen, bar);
            __builtin_amdgcn_fence(__ATOMIC_ACQUIRE, "agent");
            asm volatile("s_waitcnt vmcnt(0)" ::: "memory");
        }
    }
    __syncthreads();
}
typedef const __attribute__((address_space(4))) Args* KArgsP;
__device__ __forceinline__ KArgsP kargs() { KArgsP p = (KArgsP)__builtin_amdgcn_kernarg_segment_ptr(); asm volatile("" : "+s"(p)); return p; }
#define KA (kargs())

struct Frame {
    LAS unsigned char* lds;
    volatile LAS unsigned* MISC;
    gu32* ctl;
    int tid, lane, wave;
    int vcu, G;
};
__device__ __forceinline__ float wave_sum(float v) {
#pragma unroll
    for (int o = 1; o < 64; o <<= 1) v += __shfl_xor(v, o);
    return v;
}
__device__ __forceinline__ void p0_transpose_item(const float* W, int K, int N, bf16* WT, int k0, int n0, int dst_row0, const float* gain, LAS float* scr, int lane) {
    const int n = n0 + (lane & 31); const GAS float* Wg = (const GAS float*)W + (size_t)k0 * N + (n < N ? n : 0); const GAS float* gg = (const GAS float*)gain + k0;
#pragma unroll 1
    for (int h = 0; h < 2; ++h) {
        float wv[16]; const GAS float* Wh = Wg + (size_t)(32 * h + (lane >> 5)) * N;
#pragma unroll
        for (int i = 0; i < 16; ++i) wv[i] = Wh[(size_t)(2 * i) * N];
#pragma unroll
        for (int i = 0; i < 16; ++i) { const int kk = 32 * h + 2 * i + (lane >> 5); float w = (n < N) ? wv[i] : 0.f; if (gain) w *= gg[kk]; scr[kk * 33 + (lane & 31)] = w; }
    }
    LDS_WAIT(); asm volatile("" ::: "memory");
    const int c = lane & 7;
#pragma unroll
    for (int j = 0; j < 4; ++j) { const int nn = (lane >> 3) + 8 * j; const LAS float* s = scr + (8 * c) * 33 + nn;
        v4u o; o.x = pk2(s[0 * 33], s[1 * 33]); o.y = pk2(s[2 * 33], s[3 * 33]); o.z = pk2(s[4 * 33], s[5 * 33]); o.w = pk2(s[6 * 33], s[7 * 33]);
        *(GAS v4u*)(WT + (size_t)(dst_row0 + nn) * K + k0 + 8 * c) = o; }
    LDS_WAIT(); asm volatile("" ::: "memory");
}
__device__ __forceinline__ float cos_rev(float r) { return __builtin_amdgcn_cosf(r - floorf(r)); }
__device__ __forceinline__ float sin_rev(float r) { return __builtin_amdgcn_sinf(r - floorf(r)); }
constexpr float INV_2PI = 0.15915494309189535f;

__device__ __forceinline__ void s5_prep(Frame& F, int j, int g, int half) { const KArgsP a = KA;
    LAS float* L = (LAS float*)(F.lds + RING_OFF);
    LAS float* APr = L; LAS float* APi = L + 17 * 64; LAS float* BBr = L + 2 * 17 * 64; LAS float* BBi = BBr + 1024; LAS float* CCr = BBi + 1024; LAS float* CCi = CCr + 1024; LAS float* KK = CCi + 1024;
    const int tid = F.tid; const int jg = j * 64 + g;
    const float dt = __expf(a->in[4][jg]);
    for (int idx = tid; idx < 17 * 64; idx += 512) { const int jj = idx >> 6, p = idx & 63; const float are = a->in[2][jg * 64 + p], aim = a->in[3][jg * 64 + p];
        const float mag = __expf(are * dt * (float)jj), rev = aim * dt * (float)jj * INV_2PI; APr[idx] = mag * cos_rev(rev); APi[idx] = mag * sin_rev(rev); }
    for (int idx = tid; idx < 1024; idx += 512) { const int p = idx >> 4; const float are = a->in[2][jg * 64 + p], aim = a->in[3][jg * 64 + p];
        const float x = are * dt, rev = aim * dt * INV_2PI;
        const float em1 = x * (1.f + x * (0.5f + x * (0.16666667f + x * (0.041666668f + x * 0.008333334f))));
        const float c = cos_rev(rev), s = sin_rev(rev), sh = sin_rev(0.5f * rev);
        const float nr = em1 * c - 2.f * sh * sh, ni = (em1 + 1.f) * s;
        const float den = 1.f / (are * are + aim * aim), qr = (nr * are + ni * aim) * den, qi = (ni * are - nr * aim) * den;
        const float br = a->in[5][(size_t)jg * 1024 + idx], bi = a->in[6][(size_t)jg * 1024 + idx];
        BBr[idx] = qr * br - qi * bi; BBi[idx] = qr * bi + qi * br;
        CCr[idx] = a->in[7][(size_t)jg * 1024 + idx]; CCi[idx] = a->in[8][(size_t)jg * 1024 + idx]; }
    LDS_WAIT(); __syncthreads();
    { const int h = (tid >> 4) & 15, hp = tid & 15, j0 = (tid >> 8) * 8; float accj[8];
#pragma unroll
        for (int q = 0; q < 8; ++q) accj[q] = 0.f;
        for (int p = 0; p < 64; ++p) { const float cr = CCr[h * 64 + p], ci = CCi[h * 64 + p], br = BBr[p * 16 + hp], bi = BBi[p * 16 + hp];
            const float er = cr * br - ci * bi, ei = cr * bi + ci * br;
#pragma unroll
            for (int q = 0; q < 8; ++q) accj[q] += er * APr[(j0 + q) * 64 + p] - ei * APi[(j0 + q) * 64 + p]; }
#pragma unroll
        for (int q = 0; q < 8; ++q) KK[(j0 + q) * 256 + h * 16 + hp] = accj[q]; }
    LDS_WAIT(); __syncthreads();
    bf16* Bm = (bf16*)(a->ws + WS_S5BM) + (size_t)jg * 256 * 384;
    for (int pc = tid + half * 128 * 48; pc < (half + 1) * 128 * 48; pc += 512) { const int row = pc / 48, cp = pc % 48, t = row >> 4, h = row & 15, c0 = cp * 8; float v[8];
        if (c0 < 256) { const int s = c0 >> 4, hp0 = c0 & 15;
#pragma unroll
            for (int e = 0; e < 8; ++e) v[e] = (s <= t) ? KK[(t - s) * 256 + h * 16 + hp0 + e] : 0.f;
        } else { const int pp = c0 - 256;
#pragma unroll
            for (int e = 0; e < 8; ++e) { const int p = (pp + e) & 63; const float cr = CCr[h * 64 + p], ci = CCi[h * 64 + p], ar = APr[(t + 1) * 64 + p], ai = APi[(t + 1) * 64 + p];
                v[e] = (pp < 64) ? (cr * ar - ci * ai) : -(cr * ai + ci * ar); } }
        v4u o; o.x = pk2(v[0], v[1]); o.y = pk2(v[2], v[3]); o.z = pk2(v[4], v[5]); o.w = pk2(v[6], v[7]);
        *(GAS v4u*)(Bm + (size_t)row * 384 + c0) = o; }
    bf16* Bs = (bf16*)(a->ws + WS_S5BS) + (size_t)jg * 128 * 256;
    for (int pc = tid + half * 64 * 32; pc < (half + 1) * 64 * 32; pc += 512) { const int row = pc >> 5, cp = pc & 31, c0 = cp * 8, s = c0 >> 4, hp0 = c0 & 15; float v[8];
        if (row < 128) { const int p = row & 63; const float ar = APr[(15 - s) * 64 + p], ai = APi[(15 - s) * 64 + p];
#pragma unroll
            for (int e = 0; e < 8; ++e) { const float br = BBr[p * 16 + hp0 + e], bi = BBi[p * 16 + hp0 + e]; v[e] = (row < 64) ? (ar * br - ai * bi) : (ar * bi + ai * br); }
        } else {
#pragma unroll
            for (int e = 0; e < 8; ++e) v[e] = 0.f; }
        v4u o; o.x = pk2(v[0], v[1]); o.y = pk2(v[2], v[3]); o.z = pk2(v[4], v[5]); o.w = pk2(v[6], v[7]);
        *(GAS v4u*)(Bs + (size_t)row * 256 + c0) = o; }
    LDS_WAIT(); __syncthreads();
}

__device__ __forceinline__ void bf8_to_f32(const v4u w, float (&o)[8]) {
#pragma unroll
    for (int e = 0; e < 4; ++e) { o[2 * e] = __uint_as_float(w[e] << 16); o[2 * e + 1] = __uint_as_float(w[e] & 0xffff0000u); } }
__device__ __forceinline__ v4u f32_to_bf8(const float (&x)[8]) { v4u o; o.x = pk2(x[0], x[1]); o.y = pk2(x[2], x[3]); o.z = pk2(x[4], x[5]); o.w = pk2(x[6], x[7]); return o; }
__device__ __forceinline__ void norm_pass(Frame& F, const float* hsrc32, bf16* H16, const bf16* mix, const float* gpost, int premode, const float* gpre, bf16* AS5, float* out32, float* rowinv, bool wr_h, const bf16* wf = nullptr, const float* bfv = nullptr, float* LF = nullptr) {
    const int gw = F.vcu * NWAVES + F.wave, NGW = F.G * NWAVES; int lane_ = F.lane; asm volatile("" : "+v"(lane_)); const int lane = lane_;
    f32x4 gpo[2][2], gpr[2][2];
#pragma unroll
    for (int j = 0; j < 2; ++j) { const f32x4 z = {0.f, 0.f, 0.f, 0.f}; gpo[j][0] = z; gpo[j][1] = z; gpr[j][0] = z; gpr[j][1] = z;
        if (mix) { const GAS f32x4* gp = (const GAS f32x4*)(gpost + 8 * lane + 512 * j); gpo[j][0] = gp[0]; gpo[j][1] = gp[1]; }
        if (premode == 2) { const GAS f32x4* gp = (const GAS f32x4*)(gpre + 8 * lane + 512 * j); gpr[j][0] = gp[0]; gpr[j][1] = gp[1]; } }
    v4u wfr[16][2];
#pragma unroll
    for (int hh = 0; hh < 16; ++hh)
#pragma unroll
        for (int j = 0; j < 2; ++j) { const v4u z = {0u, 0u, 0u, 0u}; wfr[hh][j] = wf ? *(const GAS v4u*)(wf + (size_t)hh * D + 8 * lane + 512 * j) : z; }
    for (int m0 = gw; m0 < M; m0 += 2 * NGW) {
        float v[2][2][8]; v4u mw[2][2];
#pragma unroll
        for (int r = 0; r < 2; ++r) { const int m = m0 + r * NGW;
            if (hsrc32) {
#pragma unroll
                for (int j = 0; j < 2; ++j) { const GAS f32x4* xr = (const GAS f32x4*)(hsrc32 + (size_t)m * D + 8 * lane + 512 * j); const f32x4 a = xr[0], b = xr[1];
                    v[r][j][0] = a.x; v[r][j][1] = a.y; v[r][j][2] = a.z; v[r][j][3] = a.w; v[r][j][4] = b.x; v[r][j][5] = b.y; v[r][j][6] = b.z; v[r][j][7] = b.w; }
            } else {
#pragma unroll
                for (int j = 0; j < 2; ++j) { const v4u w = *(const GAS v4u*)(H16 + (size_t)m * D + 8 * lane + 512 * j); bf8_to_f32(w, v[r][j]); } }
            if (mix) {
#pragma unroll
                for (int j = 0; j < 2; ++j) mw[r][j] = *(const GAS v4u*)(mix + (size_t)m * D + 8 * lane + 512 * j); } }
#pragma unroll
        for (int r = 0; r < 2; ++r) { const int m = m0 + r * NGW;
            if (mix) {
                float x[2][8]; float s = 0.f;
#pragma unroll
                for (int j = 0; j < 2; ++j) { bf8_to_f32(mw[r][j], x[j]);
#pragma unroll
                    for (int e = 0; e < 8; ++e) s += x[j][e] * x[j][e]; }
                const float rr = 1.f / sqrtf(wave_sum(s) * (1.f / D) + RMS_EPS);
#pragma unroll
                for (int j = 0; j < 2; ++j) { const f32x4 ga = gpo[j][0], gb = gpo[j][1];
                    v[r][j][0] += x[j][0] * rr * ga.x; v[r][j][1] += x[j][1] * rr * ga.y; v[r][j][2] += x[j][2] * rr * ga.z; v[r][j][3] += x[j][3] * rr * ga.w;
                    v[r][j][4] += x[j][4] * rr * gb.x; v[r][j][5] += x[j][5] * rr * gb.y; v[r][j][6] += x[j][6] * rr * gb.z; v[r][j][7] += x[j][7] * rr * gb.w; }
            }
            if (premode == 0) {
#pragma unroll
                for (int j = 0; j < 2; ++j) { GAS f32x4* orow = (GAS f32x4*)(out32 + (size_t)m * D + 8 * lane + 512 * j);
                    orow[0] = (f32x4){v[r][j][0], v[r][j][1], v[r][j][2], v[r][j][3]}; orow[1] = (f32x4){v[r][j][4], v[r][j][5], v[r][j][6], v[r][j][7]}; }
            } else {
                v4u hpk[2];
#pragma unroll
                for (int j = 0; j < 2; ++j) hpk[j] = f32_to_bf8(v[r][j]);
                if (wr_h) {
#pragma unroll
                    for (int j = 0; j < 2; ++j) *(GAS v4u*)(H16 + (size_t)m * D + 8 * lane + 512 * j) = hpk[j]; }
                float s2 = 0.f;
#pragma unroll
                for (int j = 0; j < 2; ++j)
#pragma unroll
                    for (int e = 0; e < 8; ++e) s2 += v[r][j][e] * v[r][j][e];
                const float inv = 1.f / sqrtf(wave_sum(s2) * (1.f / D) + RMS_EPS);
                if (premode == 1) { if (lane == 0) rowinv[m] = inv;
                    if (wf) {
                        typedef __bf16 bf16x2_t __attribute__((ext_vector_type(2)));
                        const unsigned hw[8] = {hpk[0].x, hpk[0].y, hpk[0].z, hpk[0].w, hpk[1].x, hpk[1].y, hpk[1].z, hpk[1].w};
                        float q8[8], q4[4], q2[2], q1;
                        { const bool up = (lane & 32) != 0;
#pragma unroll
                          for (int i = 0; i < 8; ++i) { float pa = 0.f, pb = 0.f;
                              const unsigned wa[8] = {wfr[i][0].x, wfr[i][0].y, wfr[i][0].z, wfr[i][0].w, wfr[i][1].x, wfr[i][1].y, wfr[i][1].z, wfr[i][1].w};
                              const unsigned wb[8] = {wfr[i + 8][0].x, wfr[i + 8][0].y, wfr[i + 8][0].z, wfr[i + 8][0].w, wfr[i + 8][1].x, wfr[i + 8][1].y, wfr[i + 8][1].z, wfr[i + 8][1].w};
#pragma unroll
                              for (int e = 0; e < 8; ++e) { pa = __builtin_amdgcn_fdot2_f32_bf16(__builtin_bit_cast(bf16x2_t, hw[e]), __builtin_bit_cast(bf16x2_t, wa[e]), pa, false);
                                                            pb = __builtin_amdgcn_fdot2_f32_bf16(__builtin_bit_cast(bf16x2_t, hw[e]), __builtin_bit_cast(bf16x2_t, wb[e]), pb, false); }
                              const float keep = up ? pb : pa, send = up ? pa : pb; q8[i] = keep + __shfl_xor(send, 32); } }
                        { const bool up = (lane & 16) != 0;
#pragma unroll
                          for (int i = 0; i < 4; ++i) { const float keep = up ? q8[i + 4] : q8[i], send = up ? q8[i] : q8[i + 4]; q4[i] = keep + __shfl_xor(send, 16); } }
                        { const bool up = (lane & 8) != 0;
#pragma unroll
                          for (int i = 0; i < 2; ++i) { const float keep = up ? q4[i + 2] : q4[i], send = up ? q4[i] : q4[i + 2]; q2[i] = keep + __shfl_xor(send, 8); } }
                        { const bool up = (lane & 4) != 0; const float keep = up ? q2[1] : q2[0], send = up ? q2[0] : q2[1]; q1 = keep + __shfl_xor(send, 4); }
                        q1 += __shfl_xor(q1, 2); q1 += __shfl_xor(q1, 1);
                        if ((lane & 3) == 0) { const int hh = lane >> 2; const float x = q1 * inv + bfv[hh]; LF[(size_t)m * 16 + hh] = fminf(x, 0.f) - __logf(1.0f + __expf(-fabsf(x))); }
                    } }
                else {
                    const int sc = m >> 4, t = m & 15;
#pragma unroll
                    for (int j = 0; j < 2; ++j) { const f32x4 ga = gpr[j][0], gb = gpr[j][1]; float w[8];
                        w[0] = v[r][j][0] * inv * ga.x; w[1] = v[r][j][1] * inv * ga.y; w[2] = v[r][j][2] * inv * ga.z; w[3] = v[r][j][3] * inv * ga.w;
                        w[4] = v[r][j][4] * inv * gb.x; w[5] = v[r][j][5] * inv * gb.y; w[6] = v[r][j][6] * inv * gb.z; w[7] = v[r][j][7] * inv * gb.w;
                        const int g = (lane >> 1) + 32 * j;
                        *(GAS v4u*)(AS5 + ((size_t)g * NSC + sc) * S5KA + t * 16 + 8 * (lane & 1)) = f32_to_bf8(w); }
                }
            }
        }
    }
}

__device__ __forceinline__ void s5_carry(Frame& F, int j) { const KArgsP a = KA;
    if (F.wave < 2) {
        int p_ = F.lane; asm volatile("" : "+v"(p_)); const int item = F.wave * 256 + (int)blockIdx.x; const int g = item >> 3, b = item & 7, p = p_; const int jg = j * 64 + g;
        const float dt = __expf(a->in[4][jg]); const float are = a->in[2][jg * 64 + p], aim = a->in[3][jg * 64 + p];
        const float mag = __expf(are * dt * 16.f), rev = aim * dt * 16.f * INV_2PI; const float ar = mag * cos_rev(rev), ai = mag * sin_rev(rev);
        const float* SL = (const float*)(a->ws + WS_SL) + ((size_t)g * NSC + b * 256) * 128;
        bf16* AS = (bf16*)(a->ws + WS_AS5) + ((size_t)g * NSC + b * 256) * S5KA + 256;
        float xr = 0.f, xi = 0.f;
#pragma unroll 16
        for (int sc = 0; sc < 256; ++sc) {
            const float lr = SL[(size_t)sc * 128 + p], li = SL[(size_t)sc * 128 + 64 + p];
            AS[(size_t)sc * S5KA + p] = (bf16)f2bf(xr); AS[(size_t)sc * S5KA + 64 + p] = (bf16)f2bf(xi);
            const float nr = ar * xr - ai * xi + lr, ni = ar * xi + ai * xr + li; xr = nr; xi = ni;
        }
    }
}

__device__ __forceinline__ void fox_cumsum(Frame& F, int j) { const KArgsP a = KA;
    if (blockIdx.x < NB * H) {
        int tid_ = F.tid; asm volatile("" : "+v"(tid_)); const int bh = blockIdx.x, b = bh >> 4, h = bh & 15, tid = tid_; const int lane_ = tid & 63;
        const float* LF = (const float*)(a->ws + WS_LF_OF(j)) + ((size_t)b * T + 8 * tid) * 16 + h;
        float v[8]; float run = 0.f;
#pragma unroll
        for (int i = 0; i < 8; ++i) { run += LF[i * 16]; v[i] = run; }
        float x = run;
#pragma unroll
        for (int o = 1; o < 64; o <<= 1) { const float tt = __shfl_up(x, o); if (lane_ >= o) x += tt; }
        LAS float* wt = (LAS float*)(F.lds + RING_OFF);
        if (lane_ == 63) wt[F.wave] = x;
        LDS_WAIT(); __syncthreads();
        float pre = x - run;
        for (int w = 0; w < F.wave; ++w) pre += wt[w];
        float* o = (float*)(a->ws + WS_CK2) + (size_t)bh * T + 8 * tid;
        const float L2E = 1.4426950408889634f;
        *(f32x4*)o = (f32x4){(pre + v[0]) * L2E, (pre + v[1]) * L2E, (pre + v[2]) * L2E, (pre + v[3]) * L2E};
        *(f32x4*)(o + 4) = (f32x4){(pre + v[4]) * L2E, (pre + v[5]) * L2E, (pre + v[6]) * L2E, (pre + v[7]) * L2E};
        LDS_WAIT(); __syncthreads();
    }
}

__device__ __forceinline__ void fox_norms(Frame& F, int j) {
    const KArgsP a = KA; int lane_ = F.lane; asm volatile("" : "+v"(lane_)); const int lane = lane_;
    const int gw = F.vcu * NWAVES + F.wave, NGW = F.G * NWAVES;
    for (int task = gw; task < M / 16; task += NGW) {
        const int m0 = task * 16; float qmx = 0.f, kmx = 0.f, dmx = 0.f;
#pragma unroll 4
        for (int r = 0; r < 16; ++r) {
            const v4u* qp = (const v4u*)((const bf16*)(a->ws + WS_Q) + (size_t)(m0 + r) * D + 16 * lane); const v4u* kp = (const v4u*)((const bf16*)(a->ws + WS_K) + (size_t)(m0 + r) * D + 16 * lane);
            const v4u q0 = qp[0], q1 = qp[1], k0 = kp[0], k1 = kp[1]; float sq = 0.f, sk = 0.f, sd = 0.f;
#pragma unroll
            for (int e = 0; e < 4; ++e) { float x;
                float y;
                x = __uint_as_float(q0[e] << 16); y = __uint_as_float(k0[e] << 16); sq += x * x; sk += y * y; sd += x * y;
                x = __uint_as_float(q0[e] & 0xffff0000u); y = __uint_as_float(k0[e] & 0xffff0000u); sq += x * x; sk += y * y; sd += x * y;
                x = __uint_as_float(q1[e] << 16); y = __uint_as_float(k1[e] << 16); sq += x * x; sk += y * y; sd += x * y;
                x = __uint_as_float(q1[e] & 0xffff0000u); y = __uint_as_float(k1[e] & 0xffff0000u); sq += x * x; sk += y * y; sd += x * y; }
            sq += __shfl_xor(sq, 1); sq += __shfl_xor(sq, 2); sk += __shfl_xor(sk, 1); sk += __shfl_xor(sk, 2); sd += __shfl_xor(sd, 1); sd += __shfl_xor(sd, 2);
            qmx = fmaxf(qmx, sq); kmx = fmaxf(kmx, sk); dmx = fmaxf(dmx, -sd);
        }
        if ((lane & 3) == 0) { const int b = m0 >> 12, qb = (m0 & 4095) >> 8, bh = b * 16 + (lane >> 2);
            __hip_atomic_fetch_max((unsigned*)(F.ctl + CW_QN2) + j * 2048 + bh * 16 + qb, __float_as_uint(qmx * 1.02f), RLX_AGENT);
            __hip_atomic_fetch_max((unsigned*)(F.ctl + CW_KN2) + j * 128 + bh, __float_as_uint(kmx * 1.02f), RLX_AGENT);
            __hip_atomic_fetch_max((unsigned*)(F.ctl + CW_DG2) + j * 2048 + bh * 16 + qb, __float_as_uint(dmx * 1.01f + 0.05f), RLX_AGENT); }
    }
}

__device__ __forceinline__ void p0_prologue(Frame& F, bool do_w, bool do_n) {
    if (do_w) s5_prep(F, ((int)blockIdx.x >> 6) & 1, (int)blockIdx.x & 63, (int)blockIdx.x >> 7);
    const KArgsP a = KA;
    const float* gains = a->in[1];
    if (do_w) {
    LAS float* scr = (LAS float*)(F.lds + RING_OFF + F.wave * 16384);
    const int gw = F.vcu * NWAVES + F.wave, NGW = F.G * NWAVES;
    constexpr int I_GLU = 16 * 64, I_WIN = 16 * 128, I_WOUT = 16 * 32, I_W1 = 16 * 128, I_W2 = 64 * 32, I_Z = 16;
    constexpr int NITEMS = 2 * I_GLU + 2 * I_WIN + 2 * I_WOUT + 4 * I_W1 + 4 * I_W2 + 2 * I_Z;
    for (int it = gw; it < NITEMS; it += NGW) {
        int r = it;
        if (r < 2 * I_GLU) { const int j = r / I_GLU; r -= j * I_GLU; const int kb = r >> 6, nb = r & 63, n0 = nb * 32;
            const int dst = (n0 < 1024) ? ((n0 >> 7) * 256 + (n0 & 127)) : ((((n0 - 1024) >> 7) * 256) + 128 + ((n0 - 1024) & 127));
            p0_transpose_item(a->in[10] + (size_t)j * 1024 * 2048, 1024, 2048, (bf16*)(a->ws + WS_WGLU) + (size_t)j * 2048 * 1024, kb * 64, n0, dst, nullptr, scr, F.lane); continue; }
        r -= 2 * I_GLU;
        if (r < 2 * I_WIN) { const int j = r / I_WIN; r -= j * I_WIN; const int kb = r >> 7, nb = r & 127, n0 = nb * 32;
            p0_transpose_item(a->in[11] + (size_t)j * 1024 * NPROJ_REAL, 1024, NPROJ_REAL, (bf16*)(a->ws + WS_WIN) + (size_t)j * NPROJ * 1024, kb * 64, n0, n0, gains + (size_t)(2 * j + 1) * 4 * D, scr, F.lane); continue; }
        r -= 2 * I_WIN;
        if (r < 2 * I_WOUT) { const int j = r / I_WOUT; r -= j * I_WOUT; const int kb = r >> 5, nb = r & 31, n0 = nb * 32;
            p0_transpose_item(a->in[13] + (size_t)j * 1024 * 1024, 1024, 1024, (bf16*)(a->ws + WS_WOUT) + (size_t)j * 1024 * 1024, kb * 64, n0, n0, nullptr, scr, F.lane); continue; }
        r -= 2 * I_WOUT;
        if (r < 4 * I_W1) { const int i = r / I_W1; r -= i * I_W1; const int kb = r >> 7, nb = r & 127, n0 = nb * 32;
            p0_transpose_item(a->in[14] + (size_t)i * 1024 * 4096, 1024, 4096, (bf16*)(a->ws + WS_W1) + (size_t)i * 4096 * 1024, kb * 64, n0, n0, gains + (size_t)i * 4 * D + 2 * D, scr, F.lane); continue; }
        r -= 4 * I_W1;
        if (r < 4 * I_W2) { const int i = r / I_W2; r -= i * I_W2; const int kb = r >> 5, nb = r & 31, n0 = nb * 32;
            p0_transpose_item(a->in[15] + (size_t)i * 4096 * 1024, 4096, 1024, (bf16*)(a->ws + WS_W2) + (size_t)i * 1024 * 4096, kb * 64, n0, n0, nullptr, scr, F.lane); continue; }
        r -= 4 * I_W2;
        { const int j = r / I_Z, hh = r % I_Z;
            const GAS float* wsrc = (const GAS float*)(a->in[11] + (size_t)j * 1024 * NPROJ_REAL) + 4096 + hh; const GAS float* gsrc = (const GAS float*)(gains + (size_t)(2 * j + 1) * 4 * D);
            float w[16];
#pragma unroll
            for (int e = 0; e < 16; ++e) w[e] = wsrc[(size_t)(16 * F.lane + e) * NPROJ_REAL] * gsrc[16 * F.lane + e];
            GAS v4u* dst = (GAS v4u*)((bf16*)(F.ctl + CW_WF) + ((size_t)j * 16 + hh) * 1024 + 16 * F.lane);
            v4u o0, o1; o0.x = pk2(w[0], w[1]); o0.y = pk2(w[2], w[3]); o0.z = pk2(w[4], w[5]); o0.w = pk2(w[6], w[7]); o1.x = pk2(w[8], w[9]); o1.y = pk2(w[10], w[11]); o1.z = pk2(w[12], w[13]); o1.w = pk2(w[14], w[15]);
            dst[0] = o0; dst[1] = o1; }
    }
    }
    if (do_n) norm_pass(F, a->in[0], nullptr, nullptr, nullptr, 2, gains, (bf16*)(a->ws + WS_AS5), nullptr, nullptr, false);
}

__global__ void __launch_bounds__(NWAVES * 64, 2) mk_fwd(Args args_unused) {
    extern __shared__ __attribute__((aligned(16))) unsigned char lds[];
    Frame F;
    F.lds = (LAS unsigned char*)lds;
    F.MISC = (volatile LAS unsigned*)(F.lds + MISC_OFF);
    F.tid = threadIdx.x; F.lane = F.tid & 63; F.wave = __builtin_amdgcn_readfirstlane(F.tid >> 6);
    F.G = gridDim.x; { const int bx = blockIdx.x; F.vcu = (F.G % 8 == 0) ? (bx % 8) * (F.G / 8) + bx / 8 : bx; }
    F.ctl = (gu32*)(KA->ws + WS_CTL);
    for (int u = F.tid; u < (LDS_BYTES - LDSCTL_OFF) / 4; u += NWAVES * 64) ((LAS unsigned*)(F.lds + LDSCTL_OFF))[u] = 0u;
    __syncthreads();
    XcdBarrier bar = xcd_barrier_post((unsigned*)(F.ctl + CW_BAR), F.MISC + 8);
#define GRID_BAR() do { XcdBarrier b_ = bar; asm volatile("" : "+s"(b_.bar), "+s"(b_.x)); xcd_barrier(b_); } while (0)
#define WSP(T_, off) ((T_*)(KA->ws + (off)))
#define GAINS(i_, k_) (KA->in[1] + (size_t)(i_) * 4 * D + (size_t)(k_) * D)

#ifndef SKIP_PRO
    p0_prologue(F, true, true);
#ifdef PROBE_PRO_W
    GRID_BAR(); p0_prologue(F, true, false);
#endif
#ifdef PROBE_PRO_N
    GRID_BAR(); p0_prologue(F, false, true);
#endif
#endif
    if (F.G != 256) cooperative_groups::this_grid().sync();
    GRID_BAR();
#ifdef PROBE_BAR
    for (int pb = 0; pb < 20; ++pb) GRID_BAR();
#endif
#ifdef PROBE_CGSYNC
    for (int pb = 0; pb < 20; ++pb) cooperative_groups::this_grid().sync();
#endif
#if NSUB == 0
    norm_pass(F, KA->in[0], nullptr, nullptr, nullptr, 0, nullptr, nullptr, KA->out, nullptr, false);
#else
    for (int i = 0; i < DEPTH; ++i) {
        if (2 * i >= NSUB) break;
        const int j = i >> 1;
        if ((i & 1) == 0) {
#ifndef SKIP_S5LOC
            for (int k = 0; k < 2; ++k) {
              pg8::Gemm g{WSP(const bf16, WS_AS5), WSP(const bf16, WS_S5BS) + (size_t)j * 64 * 128 * 256, 64 * NSC, 256, 256, S5KA, 256, 128}; const pg8::S5OneOrder S{256 * k + F.vcu};
              pg8::EpiS5LocCarry E{WSP(bf16, WS_AS5), KA->in[2] + (size_t)j * 4096, KA->in[3] + (size_t)j * 4096, KA->in[4] + (size_t)j * 64};
              pg8::gemm_phase<pg8::EpiS5LocCarry, pg8::S5OneOrder, false, true>(F.lds + RING_OFF, g, S, E); }
#endif
            asm volatile("s_waitcnt vmcnt(0)" ::: "memory"); __syncthreads();
#ifndef SKIP_S5MAIN
            { pg8::Gemm g{WSP(const bf16, WS_AS5), WSP(const bf16, WS_S5BM) + (size_t)j * 64 * 256 * 384, 64 * NSC, 256, 384, S5KA, 384, 256}; pg8::S5Order S; S.init(F.G, F.vcu);
              pg8::EpiS5Main E{WSP(bf16, WS_G), WSP(const bf16, WS_AS5), KA->in[9] + (size_t)j * D};
              pg8::gemm_phase<pg8::EpiS5Main, pg8::S5Order, true, true>(F.lds + RING_OFF, g, S, E); }
#ifdef PROBE_S5MAIN
            GRID_BAR();
            { pg8::Gemm g{WSP(const bf16, WS_AS5), WSP(const bf16, WS_S5BM) + (size_t)j * 64 * 256 * 384, 64 * NSC, 256, 384, S5KA, 384, 256}; pg8::S5Order S; S.init(F.G, F.vcu);
              pg8::EpiS5Main E{WSP(bf16, WS_G), WSP(const bf16, WS_AS5), KA->in[9] + (size_t)j * D};
              pg8::gemm_phase<pg8::EpiS5Main, pg8::S5Order, true, true>(F.lds + RING_OFF, g, S, E); }
#endif
#endif
            GRID_BAR();
#ifndef SKIP_GLU
            { pg8::Gemm g{WSP(const bf16, WS_G), WSP(const bf16, WS_WGLU) + (size_t)j * 2048 * 1024, M, 2048, D, D, D, 256}; pg8::StaticOrder S; S.init(M, 2048, F.G, (int)blockIdx.x, WGM_GLU);
              pg8::EpiGLU E{WSP(bf16, WS_XN), D};
              pg8::gemm_phase<pg8::EpiGLU, pg8::StaticOrder, true, true>(F.lds + RING_OFF, g, S, E); }
#ifdef PROBE_GLU
            GRID_BAR();
            { pg8::Gemm g{WSP(const bf16, WS_G), WSP(const bf16, WS_WGLU) + (size_t)j * 2048 * 1024, M, 2048, D, D, D, 256}; pg8::StaticOrder S; S.init(M, 2048, F.G, (int)blockIdx.x, WGM_GLU);
              pg8::EpiGLU E{WSP(bf16, WS_XN), D};
              pg8::gemm_phase<pg8::EpiGLU, pg8::StaticOrder, true, true>(F.lds + RING_OFF, g, S, E); }
#endif
#endif
        } else {
#ifndef SKIP_PROJ
            { pg8::Gemm g{WSP(const bf16, WS_H16), WSP(const bf16, WS_WIN) + (size_t)j * NPROJ * 1024, M, NPROJ, D, D, D, 256}; pg8::StaticOrder S; S.init(M, NPROJ, F.G, (int)blockIdx.x, WGM_PROJ);
              pg8::EpiProj E{WSP(bf16, WS_Q), (size_t)M * D, attn_body::C2, (const float*)(F.ctl + CW_ROWINV)};
              pg8::gemm_phase<pg8::EpiProj, pg8::StaticOrder, true, true>(F.lds + RING_OFF, g, S, E); }
#ifdef PROBE_PROJ
            GRID_BAR();
            { pg8::Gemm g{WSP(const bf16, WS_H16), WSP(const bf16, WS_WIN) + (size_t)j * NPROJ * 1024, M, NPROJ, D, D, D, 256}; pg8::StaticOrder S; S.init(M, NPROJ, F.G, (int)blockIdx.x, WGM_PROJ);
              pg8::EpiProj E{WSP(bf16, WS_Q), (size_t)M * D, attn_body::C2, (const float*)(F.ctl + CW_ROWINV)};
              pg8::gemm_phase<pg8::EpiProj, pg8::StaticOrder, true, true>(F.lds + RING_OFF, g, S, E); }
#endif
#endif
            GRID_BAR();
#ifndef SKIP_CUMSUM
            fox_cumsum(F, j);
            fox_norms(F, j);
#endif
            GRID_BAR();
#ifndef SKIP_ATTN
            { const attn_body::AttnTensors AT{WSP(const attn_body::bf16, WS_Q), WSP(const attn_body::bf16, WS_K), WSP(const attn_body::bf16, WS_V), WSP(const attn_body::bf16, WS_GATE), WSP(const float, WS_CK2), (const unsigned*)(F.ctl + CW_QN2) + j * 2048, (const unsigned*)(F.ctl + CW_KN2) + j * 128, (const unsigned*)(F.ctl + CW_DG2) + j * 2048, WSP(attn_body::bf16, WS_Q)};
              const attn_body::QueueOrder S{(unsigned*)(F.ctl + CW_QCTR) + 64 * j, F.MISC + 16};
              attn_body::attn_phase<attn_body::QueueOrder>((char*)lds + RING_OFF, AT, S); }
#endif
            GRID_BAR();
#ifndef SKIP_WO
            { pg8::Gemm g{WSP(const bf16, WS_Q), WSP(const bf16, WS_WOUT) + (size_t)j * 1024 * 1024, M, D, D, D, D, 256}; pg8::StaticOrder S; S.init(M, D, F.G, (int)blockIdx.x, WGM_WO);
              pg8::EpiPlain E{WSP(bf16, WS_XN), D};
              pg8::gemm_phase<pg8::EpiPlain, pg8::StaticOrder, true, true>(F.lds + RING_OFF, g, S, E); }
#ifdef PROBE_WO
            GRID_BAR();
            { pg8::Gemm g{WSP(const bf16, WS_Q), WSP(const bf16, WS_WOUT) + (size_t)j * 1024 * 1024, M, D, D, D, D, 256}; pg8::StaticOrder S; S.init(M, D, F.G, (int)blockIdx.x, WGM_WO);
              pg8::EpiPlain E{WSP(bf16, WS_XN), D};
              pg8::gemm_phase<pg8::EpiPlain, pg8::StaticOrder, true, true>(F.lds + RING_OFF, g, S, E); }
#endif
#endif
        }
        GRID_BAR();
        const bool lastsub = (2 * i + 1 >= NSUB);
        norm_pass(F, i == 0 ? KA->in[0] : (const float*)nullptr, WSP(bf16, WS_H16), WSP(const bf16, WS_XN), GAINS(i, 1), lastsub ? 0 : 1, nullptr, nullptr, KA->out, (float*)(F.ctl + CW_ROWINV), true);
        if (lastsub) break;
        GRID_BAR();
#ifndef SKIP_MLP
        { pg8::Gemm g{WSP(const bf16, WS_H16), WSP(const bf16, WS_W1) + (size_t)i * 4096 * 1024, M, FF, D, D, D, 256}; pg8::StaticOrder S; S.init(M, FF, F.G, (int)blockIdx.x, WGM_MLP1);
          pg8::EpiRelu2 E{WSP(bf16, WS_BIG), FF, (const float*)(F.ctl + CW_ROWINV)};
          pg8::gemm_phase<pg8::EpiRelu2, pg8::StaticOrder, true, true>(F.lds + RING_OFF, g, S, E); }
#ifdef PROBE_MLP1
            GRID_BAR();
        { pg8::Gemm g{WSP(const bf16, WS_H16), WSP(const bf16, WS_W1) + (size_t)i * 4096 * 1024, M, FF, D, D, D, 256}; pg8::StaticOrder S; S.init(M, FF, F.G, (int)blockIdx.x, WGM_MLP1);
          pg8::EpiRelu2 E{WSP(bf16, WS_BIG), FF, (const float*)(F.ctl + CW_ROWINV)};
          pg8::gemm_phase<pg8::EpiRelu2, pg8::StaticOrder, true, true>(F.lds + RING_OFF, g, S, E); }
#endif
        GRID_BAR();
        { pg8::Gemm g{WSP(const bf16, WS_BIG), WSP(const bf16, WS_W2) + (size_t)i * 1024 * 4096, M, D, FF, FF, FF, 256}; pg8::StaticOrder S; S.init(M, D, F.G, (int)blockIdx.x, WGM_MLP2);
          pg8::EpiPlain E{WSP(bf16, WS_XN), D};
          pg8::gemm_phase<pg8::EpiPlain, pg8::StaticOrder, true, true>(F.lds + RING_OFF, g, S, E); }
#ifdef PROBE_MLP2
            GRID_BAR();
        { pg8::Gemm g{WSP(const bf16, WS_BIG), WSP(const bf16, WS_W2) + (size_t)i * 1024 * 4096, M, D, FF, FF, FF, 256}; pg8::StaticOrder S; S.init(M, D, F.G, (int)blockIdx.x, WGM_MLP2);
          pg8::EpiPlain E{WSP(bf16, WS_XN), D};
          pg8::gemm_phase<pg8::EpiPlain, pg8::StaticOrder, true, true>(F.lds + RING_OFF, g, S, E); }
#endif
#endif
        GRID_BAR();
        const bool fin = (2 * i + 2 >= NSUB) || (i == DEPTH - 1);
        const int premode = fin ? 0 : (((i + 1) & 1) == 0 ? 2 : 1);
        if (premode == 1)
            norm_pass(F, nullptr, WSP(bf16, WS_H16), WSP(const bf16, WS_XN), GAINS(i, 3), 1, nullptr, nullptr, nullptr, (float*)(F.ctl + CW_ROWINV), true,
                      (const bf16*)(F.ctl + CW_WF) + (size_t)(i >> 1) * 16 * 1024, KA->in[12] + (size_t)(i >> 1) * H, WSP(float, WS_LF_OF(i >> 1)));
        else
            norm_pass(F, nullptr, WSP(bf16, WS_H16), WSP(const bf16, WS_XN), GAINS(i, 3), premode, GAINS(i + 1 < DEPTH ? i + 1 : i, 0), WSP(bf16, WS_AS5), KA->out, (float*)(F.ctl + CW_ROWINV), true);
        if (fin) break;
        GRID_BAR();
    }
#endif
}

extern "C" void kernel_launch(void* const* d_in, const int* in_sizes, int n_in, void* d_out, int out_size, void* d_ws, size_t ws_size, hipStream_t stream) {
    static int grid = 0;
    if (grid == 0) {
        if (n_in != 16 || in_sizes[0] != M * D || out_size != M * D || ws_size < WS_END) { fprintf(stderr, "kernel_launch: unexpected shapes (n_in %d, in0 %d, out %d, ws %zu); nothing launched\n", n_in, n_in > 0 ? in_sizes[0] : -1, out_size, ws_size); grid = -1; return; }
        int dev = 0, cus = 0, per_cu = 0;
        if (hipGetDevice(&dev) != hipSuccess || hipDeviceGetAttribute(&cus, hipDeviceAttributeMultiprocessorCount, dev) != hipSuccess) { grid = -1; return; }
        if (hipFuncSetAttribute((const void*)mk_fwd, hipFuncAttributeMaxDynamicSharedMemorySize, LDS_BYTES) != hipSuccess) { fprintf(stderr, "kernel_launch: hipFuncSetAttribute failed\n"); grid = -1; return; }
        if (hipOccupancyMaxActiveBlocksPerMultiprocessor(&per_cu, (const void*)mk_fwd, NWAVES * 64, LDS_BYTES) != hipSuccess || per_cu < 1) { fprintf(stderr, "kernel_launch: occupancy query says %d\n", per_cu); per_cu = 1; }
        (void)hipGetLastError();
        grid = cus;
    }
    if (grid < 0) return;
    if (hipMemsetAsync((char*)d_ws + WS_CTL, 0, CTL_ZERO_BYTES, stream) != hipSuccess) { fprintf(stderr, "kernel_launch: hipMemsetAsync failed\n"); return; }
    Args a{};
    for (int i = 0; i < 16; ++i) a.in[i] = (const float*)d_in[i];
    a.out = (float*)d_out; a.ws = (unsigned char*)d_ws;
    void* kargv[] = {&a};
    const hipError_t le = hipLaunchCooperativeKernel((const void*)mk_fwd, dim3(grid), dim3(NWAVES * 64), kargv, LDS_BYTES, stream);
    if (le != hipSuccess) fprintf(stderr, "kernel_launch: cooperative launch failed: %s (grid %d)\n", hipGetErrorName(le), grid);
}
```

```cpp
#include <hip/hip_runtime.h>
#include <hip/hip_cooperative_groups.h>
#include <cstdio>
#include <cstdint>
#define NSUB 8
#ifndef PG8_WGM
#define PG8_WGM 8
#endif
namespace pg8 {
#define PG8_LAS __attribute__((address_space(3)))
typedef unsigned short bf16_t;
typedef short bf16x8 __attribute__((ext_vector_type(8)));
typedef float f32x4 __attribute__((ext_vector_type(4)));
typedef unsigned u32x4 __attribute__((ext_vector_type(4)));
constexpr int BM = 256, BK = 64, HALF = 128, HTB = HALF * BK * 2  , STAGE_BYTES = 8 * HTB, NXCD = 8, WGM = 8;

__host__ __device__ __forceinline__ int lds_byte(int r, int c) { const int st = (r >> 4) * 2 + (c >> 5), rr = r & 15, cc = c & 31, ob = rr * 64 + cc * 2; return st * 1024 + (ob ^ (((ob >> 9) & 1) << 5)); }
__host__ __device__ __forceinline__ void stage_rc(int b, int& R, int& C) { const int st = b / 1024, sb = b % 1024, swz = sb ^ (((sb >> 9) & 1) << 5); R = (st >> 1) * 16 + swz / 64; C = (st & 1) * 32 + (swz % 64) / 2; }
__host__ __device__ __forceinline__ int perm32(int rho) { const int n = rho >> 4, i = rho & 15; return 8 * (i >> 2) + 4 * n + (i & 3); }

struct Unit { int pm, pn; };
struct Gemm { const bf16_t* A; const bf16_t* Bt; int M, N, K, lda, ldb, bunit; };

struct StaticOrder {
    int nM, nN, nwg, G, c, wgm;
    __host__ __device__ void init(int M, int N, int G_, int c_, int wgm_ = 4) { nM = M / BM; nN = N / BM; nwg = nM * nN; G = G_; c = c_; wgm = wgm_; }
    __host__ __device__ bool next(int i, Unit& u) const {
        const long L = (long)i * G + c; if (L >= nwg) return false;
        int wgid = (int)L; { const int q = nwg / NXCD, r = nwg % NXCD, xcd = wgid % NXCD, off = wgid / NXCD; wgid = (xcd < r ? xcd * (q + 1) : r * (q + 1) + (xcd - r) * q) + off; }
        const int nig = wgm * nN, gid = wgid / nig, fm = gid * wgm, gsz = (nM - fm) < wgm ? (nM - fm) : wgm;
        u.pm = fm + ((wgid % nig) % gsz); u.pn = (wgid % nig) / gsz; return true;
    }
    __device__ __forceinline__ void a_ready(const Unit&) const {}
    __device__ __forceinline__ void done(const Unit&) const {}
};

__device__ __forceinline__ unsigned cvt_pk_bf16(float lo, float hi) { unsigned r; asm volatile("v_cvt_pk_bf16_f32 %0, %1, %2" : "=v"(r) : "v"(lo), "v"(hi)); return r; }
typedef float f32x2 __attribute__((ext_vector_type(2)));
__device__ __forceinline__ void store8(bf16_t* p, f32x4 v0, f32x4 v1) { u32x4 w; w.x = cvt_pk_bf16(v0[0], v0[1]); w.y = cvt_pk_bf16(v0[2], v0[3]); w.z = cvt_pk_bf16(v1[0], v1[1]); w.w = cvt_pk_bf16(v1[2], v1[3]); *(u32x4*)p = w; }
__device__ __forceinline__ float sigmoidf_(float x) { return __builtin_amdgcn_rcpf(1.0f + __builtin_amdgcn_exp2f(-1.4426950408889634f * x)); }
__device__ __forceinline__ float bf_lo(unsigned w) { return __uint_as_float(w << 16); }
__device__ __forceinline__ float bf_hi(unsigned w) { return __uint_as_float(w & 0xffff0000u); }

struct EpiPlain {
    static constexpr bool PERM = true, AFTER_DRAIN = false;
    bf16_t* O; int ldc;
    __device__ __forceinline__ void operator()(const f32x4 (&acc)[2][2][4][2], const Unit& u, int wr, int wc, int fr, int fq) const {
        const int row0 = u.pm * BM + wr * 64 + fr, col0 = u.pn * BM + wc * 32 + 8 * fq;
#pragma unroll
        for (int ai = 0; ai < 2; ++ai)
#pragma unroll
            for (int m = 0; m < 4; ++m) { bf16_t* rowp = O + (size_t)(row0 + ai * HALF + m * 16) * ldc + col0;
#pragma unroll
                for (int bj = 0; bj < 2; ++bj) store8(rowp + bj * HALF, acc[ai][bj][m][0], acc[ai][bj][m][1]); }
    }
};
struct EpiRelu2 {
    static constexpr bool PERM = true, AFTER_DRAIN = false;
    bf16_t* O; int ldc; const float* rowinv;
    __device__ __forceinline__ void operator()(const f32x4 (&acc)[2][2][4][2], const Unit& u, int wr, int wc, int fr, int fq) const {
        const int row0 = u.pm * BM + wr * 64 + fr, col0 = u.pn * BM + wc * 32 + 8 * fq;
        float invs[2][4];
#pragma unroll
        for (int ai = 0; ai < 2; ++ai)
#pragma unroll
            for (int m = 0; m < 4; ++m) invs[ai][m] = rowinv[row0 + ai * HALF + m * 16];
#pragma unroll
        for (int ai = 0; ai < 2; ++ai)
#pragma unroll
            for (int m = 0; m < 4; ++m) { const int row = row0 + ai * HALF + m * 16; bf16_t* rowp = O + (size_t)row * ldc + col0; const float inv = invs[ai][m];
#pragma unroll
                for (int bj = 0; bj < 2; ++bj) { f32x4 v0 = acc[ai][bj][m][0], v1 = acc[ai][bj][m][1];
#pragma unroll
                    for (int e = 0; e < 4; ++e) { const float a = fmaxf(v0[e], 0.f) * inv, b = fmaxf(v1[e], 0.f) * inv; v0[e] = a * a; v1[e] = b * b; }
                    store8(rowp + bj * HALF, v0, v1); } }
    }
};
struct EpiGLU {
    static constexpr bool PERM = true, AFTER_DRAIN = false;
    bf16_t* O; int ldc;
    __device__ __forceinline__ void operator()(const f32x4 (&acc)[2][2][4][2], const Unit& u, int wr, int wc, int fr, int fq) const {
        const int row0 = u.pm * BM + wr * 64 + fr, col0 = u.pn * HALF + wc * 32 + 8 * fq;
#pragma unroll
        for (int ai = 0; ai < 2; ++ai)
#pragma unroll
            for (int m = 0; m < 4; ++m) { bf16_t* rowp = O + (size_t)(row0 + ai * HALF + m * 16) * ldc + col0;
                f32x4 v0 = acc[ai][0][m][0], v1 = acc[ai][0][m][1]; const f32x4 g0 = acc[ai][1][m][0], g1 = acc[ai][1][m][1];
#pragma unroll
                for (int e = 0; e < 4; ++e) { v0[e] *= sigmoidf_(g0[e]); v1[e] *= sigmoidf_(g1[e]); }
                store8(rowp, v0, v1); }
    }
};
struct EpiProj {
    static constexpr bool PERM = true, AFTER_DRAIN = false;
    bf16_t* QKVG; size_t stride; float qscale; const float* rowinv;
    __device__ __forceinline__ void operator()(const f32x4 (&acc)[2][2][4][2], const Unit& u, int wr, int wc, int fr, int fq) const {
        const int row0 = u.pm * BM + wr * 64 + fr;
        float invs[2][4];
#pragma unroll
        for (int ai = 0; ai < 2; ++ai)
#pragma unroll
            for (int m = 0; m < 4; ++m) invs[ai][m] = rowinv[row0 + ai * HALF + m * 16];
        const int t = u.pn >> 2; bf16_t* base = QKVG + (size_t)t * stride; const int col0 = (u.pn & 3) * BM + wc * 32 + 8 * fq; const float sc = (t == 0) ? qscale : 1.0f;
#pragma unroll
        for (int ai = 0; ai < 2; ++ai)
#pragma unroll
            for (int m = 0; m < 4; ++m) { const int row = row0 + ai * HALF + m * 16; bf16_t* rowp = base + (size_t)row * 1024 + col0; const float sci = sc * invs[ai][m];
#pragma unroll
                for (int bj = 0; bj < 2; ++bj) store8(rowp + bj * HALF, acc[ai][bj][m][0] * sci, acc[ai][bj][m][1] * sci); }
    }
};
struct EpiS5Loc {
    static constexpr bool PERM = true, AFTER_DRAIN = false;
    float* SL;
    __device__ __forceinline__ void operator()(const f32x4 (&acc)[2][2][4][2], const Unit& u, int wr, int wc, int fr, int fq) const {
        const int row0 = u.pm * BM + wr * 64 + fr, col0 = wc * 32 + 8 * fq;
#pragma unroll
        for (int ai = 0; ai < 2; ++ai)
#pragma unroll
            for (int m = 0; m < 4; ++m) { float* rowp = SL + (size_t)(row0 + ai * HALF + m * 16) * 128 + col0; *(f32x4*)rowp = acc[ai][0][m][0]; *(f32x4*)(rowp + 4) = acc[ai][0][m][1]; }
    }
};
struct EpiS5Main {
    static constexpr bool PERM = true, AFTER_DRAIN = false;
    bf16_t* G; const bf16_t* AS5; const float* dskip;
    __device__ __forceinline__ void operator()(const f32x4 (&acc)[2][2][4][2], const Unit& u, int wr, int wc, int fr, int fq) const {
        const int g = u.pn, row0 = u.pm * BM + wr * 64 + fr;
        const int ch0 = g * 16 + 8 * (fq & 1);
        const f32x4 d0 = *(const f32x4*)(dskip + ch0), d1 = *(const f32x4*)(dskip + ch0 + 4);
#pragma unroll
        for (int ai = 0; ai < 2; ++ai) { u32x4 uus[4][2];
#pragma unroll
            for (int m = 0; m < 4; ++m)
#pragma unroll
                for (int bj = 0; bj < 2; ++bj) uus[m][bj] = *(const u32x4*)(AS5 + (size_t)(row0 + ai * HALF + m * 16) * 384 + bj * HALF + wc * 32 + 8 * fq);
#pragma unroll
            for (int m = 0; m < 4; ++m) { const int row = row0 + ai * HALF + m * 16; const int scl = row - g * 2048;
#pragma unroll
                for (int bj = 0; bj < 2; ++bj) { const int c0 = bj * HALF + wc * 32 + 8 * fq; const int t = c0 >> 4;
                    const u32x4 uu = uus[m][bj];
                    f32x4 y0 = acc[ai][bj][m][0], y1 = acc[ai][bj][m][1];
                    y0[0] += d0[0] * bf_lo(uu.x); y0[1] += d0[1] * bf_hi(uu.x); y0[2] += d0[2] * bf_lo(uu.y); y0[3] += d0[3] * bf_hi(uu.y);
                    y1[0] += d1[0] * bf_lo(uu.z); y1[1] += d1[1] * bf_hi(uu.z); y1[2] += d1[2] * bf_lo(uu.w); y1[3] += d1[3] * bf_hi(uu.w);
#pragma unroll
                    for (int e = 0; e < 4; ++e) { const float a = y0[e], b = y1[e];
                        y0[e] = a * sigmoidf_(1.5957691216057308f * (a + 0.044715f * a * a * a)); y1[e] = b * sigmoidf_(1.5957691216057308f * (b + 0.044715f * b * b * b)); }
                    store8(G + ((size_t)scl * 16 + t) * 1024 + ch0, y0, y1); } }
            asm volatile("" ::: "memory"); }
    }
};
struct S5Order {
    int G, c;
    __host__ __device__ void init(int G_, int c_) { G = G_; c = c_; }
    __host__ __device__ bool next(int i, Unit& u) const { const int L = i * G + c; if (L >= 512) return false; u.pm = L; u.pn = L >> 3; return true; }
    __device__ __forceinline__ void a_ready(const Unit&) const {}
    __device__ __forceinline__ void done(const Unit&) const {}
};

struct EpiS5LocCarry {
    static constexpr bool PERM = true, AFTER_DRAIN = true;
    bf16_t* AS5; const float* a_re; const float* a_im; const float* log_dt;
    __device__ __forceinline__ void fused(f32x4 (&acc)[2][2][4][2], const Unit& u, int wr, int wc, int fr, int fq, PG8_LAS unsigned char* lds, int wid, int lane) const {
        PG8_LAS float* T = (PG8_LAS float*)lds;
        const int col0 = wc * 32 + 8 * fq;
#pragma unroll
        for (int ai = 0; ai < 2; ++ai)
#pragma unroll
            for (int m = 0; m < 4; ++m) { PG8_LAS float* rowp = T + (ai * HALF + wr * 64 + m * 16 + fr) * 128 + col0; *(PG8_LAS f32x4*)rowp = acc[ai][0][m][0]; *(PG8_LAS f32x4*)(rowp + 4) = acc[ai][0][m][1]; }
        asm volatile("s_waitcnt lgkmcnt(0)" ::: "memory"); __builtin_amdgcn_s_barrier(); asm volatile("" ::: "memory");
        if (wid == 0) {
            const int g = u.pn, p = lane;
            const float dt = __expf(log_dt[g]); const float are = a_re[g * 64 + p], aim = a_im[g * 64 + p];
            const float mag = __expf(are * dt * 16.f), rev = aim * dt * 16.f * 0.15915494309189535f, rf = rev - floorf(rev);
            const float ar = mag * __builtin_amdgcn_cosf(rf), ai = mag * __builtin_amdgcn_sinf(rf);
            __attribute__((address_space(1))) bf16_t* AS = (__attribute__((address_space(1))) bf16_t*)(AS5 + (size_t)u.pm * BM * 384 + 256);
            float xr = 0.f, xi = 0.f;
#pragma unroll 8
            for (int sc = 0; sc < 256; ++sc) {
                const float lr = T[sc * 128 + p], li = T[sc * 128 + 64 + p];
                AS[(size_t)sc * 384 + p] = (bf16_t)(cvt_pk_bf16(xr, xr) & 0xffffu); AS[(size_t)sc * 384 + 64 + p] = (bf16_t)(cvt_pk_bf16(xi, xi) & 0xffffu);
                const float nr = ar * xr - ai * xi + lr, ni = ar * xi + ai * xr + li; xr = nr; xi = ni;
            }
        }
        asm volatile("s_waitcnt lgkmcnt(0)" ::: "memory"); __builtin_amdgcn_s_barrier(); asm volatile("" ::: "memory");
    }
};
struct S5OneOrder {
    int L;
    __host__ __device__ bool next(int i, Unit& u) const { if (i > 0 || L >= 512) return false; u.pm = L; u.pn = L >> 3; return true; }
    __device__ __forceinline__ void a_ready(const Unit&) const {}
    __device__ __forceinline__ void done(const Unit&) const {}
};

template <class Epi, class Sched, bool ALIGN_EPI = false, bool SP2 = false>
__device__ __forceinline__ void gemm_phase(PG8_LAS unsigned char* lds, const Gemm g, const Sched& S, const Epi& E) {
    int tid_ = threadIdx.x; asm volatile("" : "+v"(tid_)); const int tid = tid_, wid = __builtin_amdgcn_readfirstlane(tid >> 6), lane = tid & 63, wr = wid >> 2, wc = wid & 3, fr = lane & 15, fq = lane >> 4;
    const int K = g.K, nt = K / BK;
    unsigned voffA[2], voffB[2];
#pragma unroll
    for (int i = 0; i < 2; ++i) { int R, C; stage_rc(tid * 16 + i * 8192, R, C); const int Rb = Epi::PERM ? ((R & ~31) + perm32(R & 31)) : R;
        voffA[i] = (unsigned)(R * g.lda + C) * 2u; voffB[i] = (unsigned)(Rb * g.ldb + C) * 2u; }
    const size_t kstep = (size_t)(BK * 2);
    const size_t hstepA = (size_t)HALF * g.lda * 2, hstepB = (size_t)HALF * g.ldb * 2;
    const size_t tstepA = 2 * hstepA, tstepB = (size_t)g.bunit * g.ldb * 2;
    const unsigned ldsw = (unsigned)wid * 1024u;
    const int aoff = lds_byte(wr * 64 + fr, fq * 8), boff = lds_byte(wc * 32 + fr, fq * 8);
#define PG8_SA(b, h) (((b) * 2 + (h)) * HTB)
#define PG8_SB(b, h) ((4 + (b) * 2 + (h)) * HTB)
#define PG8_STAGE(bufoff, gbase, voff) do { _Pragma("unroll") for (int _i = 0; _i < 2; ++_i) \
        __builtin_amdgcn_global_load_lds((const unsigned*)((const char*)(gbase) + (voff)[_i]), (PG8_LAS unsigned*)(lds + (bufoff) + ldsw + _i * 8192), 16, 0, 0); } while (0)
#define PG8_LDA(dst, b, h) do { _Pragma("unroll") for (int m = 0; m < 4; ++m) _Pragma("unroll") for (int k = 0; k < 2; ++k) dst[m][k] = *(const PG8_LAS bf16x8*)(lds + PG8_SA(b, h) + aoff + m * 2048 + k * 1024); } while (0)
#define PG8_LDB(dst, b, h) do { _Pragma("unroll") for (int n = 0; n < 2; ++n) _Pragma("unroll") for (int k = 0; k < 2; ++k) dst[n][k] = *(const PG8_LAS bf16x8*)(lds + PG8_SB(b, h) + boff + n * 2048 + k * 1024); } while (0)
#define PG8_MMA(ai, bj, At, Bt) do { __builtin_amdgcn_s_setprio(1); _Pragma("unroll") for (int m = 0; m < 4; ++m) _Pragma("unroll") for (int n = 0; n < 2; ++n) _Pragma("unroll") for (int k = 0; k < 2; ++k) \
        acc[ai][bj][m][n] = __builtin_amdgcn_mfma_f32_16x16x32_bf16(Bt[n][k], At[m][k], acc[ai][bj][m][n], 0, 0, 0); __builtin_amdgcn_s_setprio(0); } while (0)
#define PG8_WAIT_V(n) asm volatile("s_waitcnt vmcnt(" #n ")" ::: "memory")
#define PG8_WAIT_L(n) asm volatile("s_waitcnt lgkmcnt(" #n ")" ::: "memory")
#define PG8_BAR __builtin_amdgcn_s_barrier()
#define PG8_SCHED __builtin_amdgcn_sched_barrier(0)
    Unit cur, nxt; int ui = 0;
    if (!S.next(0, cur)) return;
    f32x4 acc[2][2][4][2];
#pragma unroll
    for (int a = 0; a < 2; ++a)
#pragma unroll
        for (int b = 0; b < 2; ++b)
#pragma unroll
            for (int m = 0; m < 4; ++m)
#pragma unroll
                for (int n = 0; n < 2; ++n) acc[a][b][m][n] = (f32x4){0.f, 0.f, 0.f, 0.f};
    bf16x8 At[4][2], B0[2][2], B1[2][2];
    const char* cA = (const char*)g.A + (size_t)cur.pm * tstepA; const char* cB = (const char*)g.Bt + (size_t)cur.pn * tstepB;
    S.a_ready(cur);
    if constexpr (SP2) {
        PG8_STAGE(PG8_SB(0, 0), cB, voffB); PG8_STAGE(PG8_SB(0, 1), cB + hstepB, voffB); PG8_STAGE(PG8_SA(0, 0), cA, voffA); PG8_STAGE(PG8_SA(0, 1), cA + hstepA, voffA);
        if (wr == 1) PG8_BAR;
        PG8_WAIT_V(2); PG8_BAR;
        PG8_STAGE(PG8_SB(1, 0), cB + kstep, voffB); PG8_STAGE(PG8_SA(1, 0), cA + kstep, voffA); PG8_STAGE(PG8_SB(1, 1), cB + hstepB + kstep, voffB);
        PG8_WAIT_V(6); PG8_BAR;
    } else {
        PG8_STAGE(PG8_SB(0, 0), cB, voffB); PG8_STAGE(PG8_SA(0, 0), cA, voffA); PG8_STAGE(PG8_SB(0, 1), cB + hstepB, voffB); PG8_STAGE(PG8_SA(0, 1), cA + hstepA, voffA);
        if (wr == 1) PG8_BAR;
        PG8_WAIT_V(4); PG8_BAR;
        PG8_STAGE(PG8_SB(1, 0), cB + kstep, voffB); PG8_STAGE(PG8_SA(1, 0), cA + kstep, voffA); PG8_STAGE(PG8_SB(1, 1), cB + hstepB + kstep, voffB);
        PG8_WAIT_V(6); PG8_BAR;
    }
    for (;;) {
        const bool has_next = S.next(ui + 1, nxt);
        const char* nA = has_next ? (const char*)g.A + (size_t)nxt.pm * tstepA : cA; const char* nB = has_next ? (const char*)g.Bt + (size_t)nxt.pn * tstepB : cB;
_Pragma("nounroll")
        for (int t = 0; t < nt; t += 2) {
            const bool last = (t == nt - 2);
            const char* a1 = cA + (size_t)(t + 1) * kstep;
            const char* a2 = last ? nA : cA + (size_t)(t + 2) * kstep; const char* b2 = last ? nB : cB + (size_t)(t + 2) * kstep;
            const char* a3 = a2 + kstep; const char* b3 = b2 + kstep;
            if (last && has_next) S.a_ready(nxt);
            if constexpr (SP2) {
            PG8_LDB(B0, 0, 0); PG8_LDB(B1, 0, 1); PG8_SCHED; PG8_LDA(At, 0, 0); PG8_STAGE(PG8_SA(1, 1), a1 + hstepA, voffA);
            PG8_WAIT_V(8); PG8_WAIT_L(0); PG8_BAR; PG8_MMA(0, 0, At, B0); PG8_MMA(0, 1, At, B1); PG8_BAR; PG8_SCHED;
            PG8_LDA(At, 0, 1); PG8_STAGE(PG8_SB(0, 0), b2, voffB); PG8_STAGE(PG8_SB(0, 1), b2 + hstepB, voffB); PG8_STAGE(PG8_SA(0, 0), a2, voffA);
            PG8_WAIT_V(8); PG8_WAIT_L(0); PG8_BAR; PG8_MMA(1, 0, At, B0); PG8_MMA(1, 1, At, B1); PG8_BAR; PG8_SCHED;
            PG8_LDB(B0, 1, 0); PG8_LDB(B1, 1, 1); PG8_SCHED; PG8_LDA(At, 1, 0); PG8_STAGE(PG8_SA(0, 1), a2 + hstepA, voffA);
            PG8_WAIT_V(8); PG8_WAIT_L(0); PG8_BAR; PG8_MMA(0, 0, At, B0); PG8_MMA(0, 1, At, B1); PG8_BAR; PG8_SCHED;
            PG8_LDA(At, 1, 1); PG8_STAGE(PG8_SB(1, 0), b3, voffB); PG8_STAGE(PG8_SB(1, 1), b3 + hstepB, voffB); PG8_STAGE(PG8_SA(1, 0), a3, voffA);
            PG8_WAIT_V(8); PG8_WAIT_L(0); PG8_BAR; PG8_MMA(1, 0, At, B0); PG8_MMA(1, 1, At, B1); PG8_BAR; PG8_SCHED;
            } else {
            PG8_LDB(B0, 0, 0); PG8_SCHED; PG8_LDA(At, 0, 0); PG8_STAGE(PG8_SA(1, 1), a1 + hstepA, voffA);
            PG8_WAIT_L(8); PG8_BAR; PG8_WAIT_L(0); PG8_MMA(0, 0, At, B0); PG8_BAR; PG8_SCHED;
            PG8_LDB(B1, 0, 1); PG8_STAGE(PG8_SB(0, 0), b2, voffB);
            PG8_BAR; PG8_WAIT_L(0); PG8_MMA(0, 1, At, B1); PG8_BAR;
            PG8_LDA(At, 0, 1); PG8_STAGE(PG8_SA(0, 0), a2, voffA);
            PG8_BAR; PG8_WAIT_L(0); PG8_MMA(1, 0, At, B0); PG8_BAR; PG8_SCHED;
            PG8_STAGE(PG8_SB(0, 1), b2 + hstepB, voffB);
            PG8_WAIT_V(6); PG8_BAR; PG8_MMA(1, 1, At, B1); PG8_BAR;
            PG8_LDB(B0, 1, 0); PG8_SCHED; PG8_LDA(At, 1, 0); PG8_STAGE(PG8_SA(0, 1), a2 + hstepA, voffA);
            PG8_WAIT_L(8); PG8_BAR; PG8_WAIT_L(0); PG8_MMA(0, 0, At, B0); PG8_BAR; PG8_SCHED;
            PG8_LDB(B1, 1, 1); PG8_STAGE(PG8_SB(1, 0), b3, voffB);
            PG8_BAR; PG8_WAIT_L(0); PG8_MMA(0, 1, At, B1); PG8_BAR;
            PG8_LDA(At, 1, 1); PG8_STAGE(PG8_SA(1, 0), a3, voffA);
            PG8_BAR; PG8_WAIT_L(0); PG8_MMA(1, 0, At, B0); PG8_BAR; PG8_SCHED;
            PG8_STAGE(PG8_SB(1, 1), b3 + hstepB, voffB);
            PG8_WAIT_V(6); PG8_BAR; PG8_MMA(1, 1, At, B1); PG8_BAR;
            }
        }
        if constexpr (ALIGN_EPI) { if (wr == 0) PG8_BAR; }
        if constexpr (!Epi::AFTER_DRAIN) { E(acc, cur, wr, wc, fr, fq); S.done(cur); }
        if (!has_next) break;
#pragma unroll
        for (int a = 0; a < 2; ++a)
#pragma unroll
            for (int b = 0; b < 2; ++b)
#pragma unroll
                for (int m = 0; m < 4; ++m)
#pragma unroll
                    for (int n = 0; n < 2; ++n) acc[a][b][m][n] = (f32x4){0.f, 0.f, 0.f, 0.f};
        cur = nxt; cA = nA; cB = nB; ++ui;
        if constexpr (ALIGN_EPI) { if (wr == 1) PG8_BAR; }
    }
    PG8_WAIT_V(0);
    if constexpr (!ALIGN_EPI) { if (wr == 0) PG8_BAR; }
    PG8_BAR;
    if constexpr (Epi::AFTER_DRAIN) { E.fused(acc, cur, wr, wc, fr, fq, lds, wid, lane); S.done(cur); }
#undef PG8_SA
#undef PG8_SB
#undef PG8_STAGE
#undef PG8_LDA
#undef PG8_LDB
#undef PG8_MMA
#undef PG8_WAIT_V
#undef PG8_WAIT_L
#undef PG8_BAR
#undef PG8_SCHED
}
}

#define PG8_ALIGN true
#include <hip/hip_bf16.h>
#include <cmath>
namespace attn_body {
using bf16=__hip_bfloat16;
using bf16x8=__attribute__((ext_vector_type(8)))short;
using s16x4=__attribute__((ext_vector_type(4)))short;
using f32x16=__attribute__((ext_vector_type(16)))float;
using u32x4=__attribute__((ext_vector_type(4)))unsigned;
using f32x4_t=__attribute__((ext_vector_type(4)))float;
constexpr int BATCH=8,NHEAD=16,SEQ=4096,D=64,DM=NHEAD*D;
constexpr int NW=8,QBLK=32,QB=QBLK*NW,KVBLK=64,NQB=SEQ/QB;
constexpr int ATTN_PITCH=DM, ATTN_UNIT_ROWS=QB;
__device__ __forceinline__ int crow(int r,int hi){return (r&3)+8*(r>>2)+4*hi;}
#define SBAR() __builtin_amdgcn_sched_barrier(0)
__device__ __forceinline__ void cmask(f32x16&p0,f32x16&p1,int jb,int qrel,int hi){
  const float NEG=-INFINITY; int kb=64*jb+4*hi;
  #pragma unroll
  for(int r=0;r<16;++r){int kv=kb+(r&3)+8*(r>>2); if(kv>qrel)p0[r]=NEG; if(kv+32>qrel)p1[r]=NEG;}
}

constexpr int NSLOT=3, SLOTB=8192;
constexpr int LDS_K=0, LDS_V=NSLOT*SLOTB, LDS_WS=2*NSLOT*SLOTB, LDS_OST=LDS_WS+NW*64*4, LDS_CKT=LDS_OST+NW*4096, LDS_BYTES=LDS_CKT+(SEQ+64)*4;
constexpr float SKIP_THR=24.f;
constexpr float C2=0.125f*1.4426950408889634f;
__device__ __forceinline__ void glds16(const void*gsrc,unsigned lds_dst){unsigned keep;
  asm volatile("s_mov_b32 %0, m0\n\ts_mov_b32 m0, %2\n\ts_nop 0\n\tglobal_load_lds_dwordx4 %1, off\n\ts_mov_b32 m0, %0":"=&s"(keep):"v"(gsrc),"s"(lds_dst):"memory");}
__device__ __forceinline__ float max3f(float a,float b,float c){float r;asm("v_max3_f32 %0, %1, %2, %3":"=v"(r):"v"(a),"v"(b),"v"(c));return r;}
__device__ __forceinline__ float max2f(float a,float b){float r;asm("v_max_f32_e32 %0, %1, %2":"=v"(r):"v"(a),"v"(b));return r;}
__device__ __forceinline__ float fadd_s(float a,float b){float r;asm("v_add_f32_e32 %0, %1, %2":"=v"(r):"v"(a),"v"(b));return r;}
__device__ __forceinline__ float fsub_s(float a,float b){float r;asm("v_sub_f32_e32 %0, %1, %2":"=v"(r):"v"(a),"v"(b));return r;}
typedef float f32x2_t __attribute__((ext_vector_type(2))); typedef __bf16 bf16x2_t __attribute__((ext_vector_type(2)));
__device__ __forceinline__ unsigned cvtpk_s(float lo,float hi){f32x2_t v={lo,hi};bf16x2_t b=__builtin_convertvector(v,bf16x2_t);return __builtin_bit_cast(unsigned,b);}
#define WAIT_BAR(N) asm volatile("s_waitcnt vmcnt(" #N ") lgkmcnt(0)\n\ts_barrier":::"memory")

__device__ __forceinline__ void qkt(f32x16&p0,f32x16&p1,const char*Kslot,const bf16x8*qr,int r32,int hi){
  const char*kb=Kslot+hi*1024+r32*16;
  #pragma unroll
  for(int d0=0;d0<4;++d0){
    const bf16x8 b0=*reinterpret_cast<const bf16x8*>(kb+d0*2048);
    const bf16x8 b1=*reinterpret_cast<const bf16x8*>(kb+d0*2048+512);
    {p0=__builtin_amdgcn_mfma_f32_32x32x16_bf16(b0,qr[d0],p0,0,0,0);p1=__builtin_amdgcn_mfma_f32_32x32x16_bf16(b1,qr[d0],p1,0,0,0);}}
}
typedef __attribute__((address_space(3))) const char* lds_cptr;
typedef short v4i16_t __attribute__((ext_vector_type(4)));
__device__ __forceinline__ void kload8(bf16x8*kf,lds_cptr kp){
  kf[0]=*(const __attribute__((address_space(3))) bf16x8*)(kp);      kf[1]=*(const __attribute__((address_space(3))) bf16x8*)(kp+512);
  kf[2]=*(const __attribute__((address_space(3))) bf16x8*)(kp+2048); kf[3]=*(const __attribute__((address_space(3))) bf16x8*)(kp+2560);
  kf[4]=*(const __attribute__((address_space(3))) bf16x8*)(kp+4096); kf[5]=*(const __attribute__((address_space(3))) bf16x8*)(kp+4608);
  kf[6]=*(const __attribute__((address_space(3))) bf16x8*)(kp+6144); kf[7]=*(const __attribute__((address_space(3))) bf16x8*)(kp+6656);
}
__device__ __forceinline__ void kload2(bf16x8*kf,lds_cptr kp,int j){ kf[2*j]=*(const __attribute__((address_space(3))) bf16x8*)(kp+j*2048); kf[2*j+1]=*(const __attribute__((address_space(3))) bf16x8*)(kp+j*2048+512); }
__device__ __forceinline__ s16x4 vtr(lds_cptr p){ return __builtin_bit_cast(s16x4,__builtin_amdgcn_ds_read_tr16_b64_v4i16((__attribute__((address_space(3))) v4i16_t*)p)); }
__device__ __forceinline__ float rowmax(const f32x16&p0,const f32x16&p1){
  float a=max3f(p0[0],p0[1],p1[0]),b=max3f(p0[2],p0[3],p1[1]);a=max3f(a,p1[2],p1[3]);
  #pragma unroll
  for(int r=4;r<16;r+=4){a=max3f(a,p0[r],p0[r+1]);b=max3f(b,p0[r+2],p0[r+3]);a=max3f(a,p1[r],p1[r+1]);b=max3f(b,p1[r+2],p1[r+3]);}
  const float m=max2f(a,b);
  auto rr=__builtin_amdgcn_permlane32_swap(__float_as_uint(m),__float_as_uint(m),false,false);
  return max2f(__uint_as_float(rr[0]),__uint_as_float(rr[1]));
}
__device__ __forceinline__ void pv(f32x16*o,int vb,bf16x8 pa0,bf16x8 pa1,bf16x8 pa2,bf16x8 pa3){
  #pragma unroll
  for(int d0=0;d0<2;++d0){s16x4 lo[4],hi[4];
    #pragma unroll
    for(int ks=0;ks<4;++ks){
      asm volatile("ds_read_b64_tr_b16 %0,%1 offset:%c2":"=&v"(lo[ks]):"v"(vb),"i"(d0*4096+ks*1024):"memory");
      asm volatile("ds_read_b64_tr_b16 %0,%1 offset:%c2":"=&v"(hi[ks]):"v"(vb),"i"(d0*4096+ks*1024+512):"memory");}
    asm volatile("s_waitcnt lgkmcnt(0)":::"memory");SBAR();
    #define PK(k) (bf16x8){lo[k][0],lo[k][1],lo[k][2],lo[k][3],hi[k][0],hi[k][1],hi[k][2],hi[k][3]}
    o[d0]=__builtin_amdgcn_mfma_f32_32x32x16_bf16(pa0,PK(0),o[d0],0,0,0);
    o[d0]=__builtin_amdgcn_mfma_f32_32x32x16_bf16(pa1,PK(1),o[d0],0,0,0);
    o[d0]=__builtin_amdgcn_mfma_f32_32x32x16_bf16(pa2,PK(2),o[d0],0,0,0);
    o[d0]=__builtin_amdgcn_mfma_f32_32x32x16_bf16(pa3,PK(3),o[d0],0,0,0);
    #undef PK
  }
}

#ifndef ATTN_STORE16
#define ATTN_STORE16(p,v) (*(u32x4*)(p)=(v))
#endif
template<int THRL> __device__ __forceinline__ void attn_unit(int b,int h,int qb,const bf16*Q,const bf16*__restrict__ K,const bf16*__restrict__ V,const bf16*__restrict__ GT,const float*__restrict__ CK2,const unsigned*__restrict__ QN2,const unsigned*__restrict__ KN2,const unsigned*__restrict__ DG2,bf16*O,char*shm){
  int tid_=threadIdx.x; asm volatile("":"+v"(tid_)); const int tid=tid_,lane=tid&63,r32=lane&31,hi=lane>>5; const int wid=__builtin_amdgcn_readfirstlane(tid>>6);
  const long rowbase=(long)b*SEQ; const int q0=qb*QB;
  const bf16*Qw=Q+(rowbase+q0+wid*QBLK)*DM+h*D;
  const float*ckg=CK2+((long)(b*NHEAD+h))*SEQ; const int NTF=(q0+QB)/KVBLK; int tskip;
  { const float qn_=sqrtf(__uint_as_float(QN2[(b*NHEAD+h)*NQB+qb])),kn_=sqrtf(__uint_as_float(KN2[b*NHEAD+h])); const float A_=qn_*kn_+__uint_as_float(DG2[(b*NHEAD+h)*NQB+qb])+ckg[q0]+SKIP_THR;
    const float ce_=(lane<NTF)?ckg[64*lane+63]:0.f; const bool pr_=(lane<NTF)&&(A_-ce_<0.f);
    tskip=(int)__popcll(__ballot(pr_)); tskip&=~1; if(tskip>NTF-4)tskip=NTF-4; tskip=__builtin_amdgcn_readfirstlane(tskip); }
  const bf16*Kh=K+(rowbase+(long)tskip*KVBLK)*DM+h*D,*Vh=V+(rowbase+(long)tskip*KVBLK)*DM+h*D;
  const unsigned lds0=(unsigned)(uintptr_t)shm; const lds_cptr shm3=(lds_cptr)shm;
  float*wsf=(float*)(shm+LDS_WS)+wid*64;
  const bf16*ksrc=Kh+(long)lane*DM+wid*8;
  const bf16*vsrc=Vh+(long)(16*(wid&3)+(lane>>2))*DM+(wid>>2)*32+(lane&3)*8;
  const unsigned kdst=lds0+LDS_K+wid*1024, vdst=lds0+LDS_V+wid*1024;
  #define DMA_K(t,slot) glds16(ksrc+(long)(t)*KVBLK*DM,(unsigned)__builtin_amdgcn_readfirstlane(kdst+(slot)))
  #define DMA_V(t,slot) glds16(vsrc+(long)(t)*KVBLK*DM,(unsigned)__builtin_amdgcn_readfirstlane(vdst+(slot)))
  const int vb0=(int)(lds0+LDS_V)+((lane>>4)&1)*32+(lane&3)*8+(4*hi+((lane&15)>>2))*64;
  const char*Kbase=shm+LDS_K; bf16x8 kf[8];
  const lds_cptr kp0=shm3+LDS_K+hi*1024+r32*16; const lds_cptr vp0=shm3+LDS_V+((lane>>4)&1)*32+(lane&3)*8+(4*hi+((lane&15)>>2))*64;
  const int NT=NTF-tskip;
  typedef __attribute__((address_space(3))) float* lds_fptr;
  const lds_fptr ckt=(lds_fptr)(shm3+LDS_CKT);
  { const int n_=q0+QB-64*tskip; const float*cks_=ckg+64*tskip;
    for(int i_=tid*4;i_<n_;i_+=2048){ const f32x4_t v_=*(const __attribute__((address_space(1))) f32x4_t*)(cks_+i_); *(__attribute__((address_space(3))) f32x4_t*)(ckt+i_)=v_; } }
  float cq2=CK2[((long)(b*NHEAD+h))*SEQ+q0+wid*QBLK+r32];
  float base=cq2;
  #define BIAS_INIT(C0,C1,t) do{ const lds_fptr cp_=ckt+64*(t)+4*hi; \
    _Pragma("unroll") for(int j_=0;j_<4;++j_){ const f32x4_t a_=*(const __attribute__((address_space(3))) f32x4_t*)(cp_+8*j_); const f32x4_t b_=*(const __attribute__((address_space(3))) f32x4_t*)(cp_+32+8*j_); \
      C0[4*j_]=base-a_[0];C0[4*j_+1]=base-a_[1];C0[4*j_+2]=base-a_[2];C0[4*j_+3]=base-a_[3]; C1[4*j_]=base-b_[0];C1[4*j_+1]=base-b_[1];C1[4*j_+2]=base-b_[2];C1[4*j_+3]=base-b_[3]; } }while(0)
  DMA_K(0,0);DMA_V(0,0);DMA_K(1,SLOTB);
  bf16x8 qr[4];
  #pragma unroll
  for(int d0=0;d0<4;++d0)qr[d0]=*reinterpret_cast<const bf16x8*>(&Qw[(long)r32*DM+d0*16+hi*8]);
  float mhat=0.f,l_reg=0.f;f32x16 o[2];o[0]=f32x16{};o[1]=f32x16{};
  const int qrel=wid*QBLK+r32;
  #define CMASK(P0,P1,t) do{int jb_=(t)-(NT-4); if(jb_>=0)cmask(P0,P1,jb_,qrel,hi);}while(0)
  bool resc=false;
  #define START(P0,P1) do{ const float rm=rowmax(P0,P1); resc=false; \
    { const float dl=rm; mhat=fadd_s(mhat,dl); \
      _Pragma("unroll") for(int r=0;r<16;++r){P0[r]=fsub_s(P0[r],dl);P1[r]=fsub_s(P1[r],dl);} \
      base=cq2-mhat; } \
    _Pragma("unroll") for(int r=0;r<16;++r)P0[r]=__builtin_amdgcn_exp2f(P0[r]); }while(0)
  #define RESC() do{ if(resc){ asm volatile("s_waitcnt lgkmcnt(0)":::"memory"); \
      _Pragma("unroll") for(int d_=0;d_<2;++d_) _Pragma("unroll") for(int r=0;r<16;++r)o[d_][r]*=wsf[crow(r,hi)]; } }while(0)
  f32x16 pA0,pA1,pB0,pB1;
  int sl_prev=0,sl_cur=0,sl_next=SLOTB;
  #define ROT() do{sl_prev=sl_cur;sl_cur=sl_next;sl_next=(sl_next==(NSLOT-1)*SLOTB)?0:sl_next+SLOTB;}while(0)
  DMA_K(2,2*SLOTB);
  WAIT_BAR(3);
  BIAS_INIT(pA0,pA1,0); qkt(pA0,pA1,Kbase,qr,r32,hi);asm volatile("s_nop 15\n\ts_nop 7":"+v"(pA0),"+v"(pA1));CMASK(pA0,pA1,0);
  START(pA0,pA1);
  _Pragma("unroll") for(int r=0;r<16;++r)pA1[r]=__builtin_amdgcn_exp2f(pA1[r]);
  WAIT_BAR(0);
  DMA_K(3,0);DMA_V(1,SLOTB);
  ROT();
  kload8(kf,kp0+sl_cur);
  WAIT_BAR(2);
  s16x4 vlo[8],vhi[8]; u32x4 pw0,pw1,pw2,pw3;
  #define PKW(P,B) cvtpk_s(P[B],P[B+1])
  #define PAF(k) __builtin_bit_cast(bf16x8,pw##k)
  #define VFR(i) (bf16x8){vlo[i][0],vlo[i][1],vlo[i][2],vlo[i][3],vhi[i][0],vhi[i][1],vhi[i][2],vhi[i][3]}
  #define PIN(x) asm volatile("":"+v"(x))
  #define MX3(a,b,c) __builtin_fmaxf(__builtin_fmaxf((a),(b)),(c))
  #define GAPA(MF,A0,A1,A2,A3,W0,W1,PW) do{ MF; sacc+=A0; sacc+=A1; sacc+=A2; sacc+=A3; PIN(sacc); W0; W1; PIN(PW); SBAR(); }while(0)
  #define EX(v) __builtin_amdgcn_exp2f(v)
  #define GAPB(MF,X,B) do{ MF; X[B]=EX(X[B]); X[B+1]=EX(X[B+1]); X[B+2]=EX(X[B+2]); X[B+3]=EX(X[B+3]); PIN(X); SBAR(); }while(0)
  #define VRD(i) do{ vlo[i]=vtr(vp_+(((i)>>2)*4096+((i)&3)*1024)); vhi[i]=vtr(vp_+(((i)>>2)*4096+((i)&3)*1024+512)); }while(0)
  #define KRD(G,j) do{ if(G){ kload2(kf,kp0+sl_next,j); SBAR(); } }while(0)
  #define STEP(C0,C1,P0,P1,t,GK,GV,GL) do{ SBAR(); BIAS_INIT(C0,C1,t); SBAR(); \
    const lds_cptr vp_=vp0+sl_prev; \
    VRD(0); SBAR(); float sacc=(P0[0]+P0[1]); \
    GAPA(C0=__builtin_amdgcn_mfma_f32_32x32x16_bf16(kf[0],qr[0],C0,0,0,0), P0[2],P0[3],P0[4],P0[5],     pw0[0]=PKW(P0,0), pw0[1]=PKW(P0,2), pw0); \
    VRD(4); SBAR(); GAPA(C1=__builtin_amdgcn_mfma_f32_32x32x16_bf16(kf[1],qr[0],C1,0,0,0), P0[6],P0[7],P0[8],P0[9],     pw0[2]=PKW(P0,4), pw0[3]=PKW(P0,6), pw0); \
    VRD(1); SBAR(); GAPA(C0=__builtin_amdgcn_mfma_f32_32x32x16_bf16(kf[2],qr[1],C0,0,0,0),   P0[10],P0[11],P0[12],P0[13], pw1[0]=PKW(P0,8), pw1[1]=PKW(P0,10), pw1); \
    VRD(5); SBAR(); GAPA(C1=__builtin_amdgcn_mfma_f32_32x32x16_bf16(kf[3],qr[1],C1,0,0,0),   P0[14],P0[15],P1[0],P1[1],   pw1[2]=PKW(P0,12),pw1[3]=PKW(P0,14), pw1); \
    VRD(2); SBAR(); GAPA(C0=__builtin_amdgcn_mfma_f32_32x32x16_bf16(kf[4],qr[2],C0,0,0,0),   P1[2],P1[3],P1[4],P1[5],     pw2[0]=PKW(P1,0), pw2[1]=PKW(P1,2), pw2); \
    VRD(6); SBAR(); GAPA(C1=__builtin_amdgcn_mfma_f32_32x32x16_bf16(kf[5],qr[2],C1,0,0,0),   P1[6],P1[7],P1[8],P1[9],     pw2[2]=PKW(P1,4), pw2[3]=PKW(P1,6), pw2); \
    VRD(3); SBAR(); GAPA(C0=__builtin_amdgcn_mfma_f32_32x32x16_bf16(kf[6],qr[3],C0,0,0,0),   P1[10],P1[11],P1[12],P1[13], pw3[0]=PKW(P1,8), pw3[1]=PKW(P1,10), pw3); \
    VRD(7); SBAR(); GAPA(C1=__builtin_amdgcn_mfma_f32_32x32x16_bf16(kf[7],qr[3],C1,0,0,0),   P1[14],P1[15],0.f,0.f,       pw3[2]=PKW(P1,12),pw3[3]=PKW(P1,14), pw3); \
    l_reg+=sacc; \
    if(GK){DMA_K((t)+3,sl_cur);} if(GV){DMA_V((t)+1,sl_next);} \
    CMASK(C0,C1,t); \
    { float a=MX3(C0[0],C0[1],C1[0]),b=MX3(C0[2],C0[3],C1[1]); a=MX3(a,C1[2],C1[3]); \
      _Pragma("unroll") for(int r=4;r<16;r+=4){a=MX3(a,C0[r],C0[r+1]);b=MX3(b,C0[r+2],C0[r+3]);a=MX3(a,C1[r],C1[r+1]);b=MX3(b,C1[r+2],C1[r+3]);} \
      float rm=__builtin_fmaxf(a,b); { auto rr=__builtin_amdgcn_permlane32_swap(__float_as_uint(rm),__float_as_uint(rm),false,false); rm=__builtin_fmaxf(__uint_as_float(rr[0]),__uint_as_float(rr[1])); } \
      resc=false; \
      if(__builtin_expect(__any(rm>(float)THRL),0)){ const float dl=__builtin_fmaxf(rm,0.f); mhat+=dl; \
        _Pragma("unroll") for(int r=0;r<16;++r){C0[r]-=dl;C1[r]-=dl;} \
        base=cq2-mhat; \
        const float f=__builtin_amdgcn_exp2f(-dl); l_reg*=f; if(hi==0)wsf[r32]=f; resc=true; } } \
    SBAR(); \
    GAPB(o[0]=__builtin_amdgcn_mfma_f32_32x32x16_bf16(PAF(0),VFR(0),o[0],0,0,0), C0,0); \
    GAPB(o[1]=__builtin_amdgcn_mfma_f32_32x32x16_bf16(PAF(0),VFR(4),o[1],0,0,0), C0,4); \
    KRD(GL,0); GAPB(o[0]=__builtin_amdgcn_mfma_f32_32x32x16_bf16(PAF(1),VFR(1),o[0],0,0,0), C0,8); \
    KRD(GL,1); GAPB(o[1]=__builtin_amdgcn_mfma_f32_32x32x16_bf16(PAF(1),VFR(5),o[1],0,0,0), C0,12); \
    KRD(GL,2); GAPB(o[0]=__builtin_amdgcn_mfma_f32_32x32x16_bf16(PAF(2),VFR(2),o[0],0,0,0), C1,0); \
    KRD(GL,3); GAPB(o[1]=__builtin_amdgcn_mfma_f32_32x32x16_bf16(PAF(2),VFR(6),o[1],0,0,0), C1,4); \
    GAPB(o[0]=__builtin_amdgcn_mfma_f32_32x32x16_bf16(PAF(3),VFR(3),o[0],0,0,0), C1,8); \
    GAPB(o[1]=__builtin_amdgcn_mfma_f32_32x32x16_bf16(PAF(3),VFR(7),o[1],0,0,0), C1,12); \
    }while(0)
  int t=1;
  #undef CMASK
  #define CMASK(P0,P1,t) do{}while(0)
  for(;t+5<NT;t+=2){
    STEP(pB0,pB1,pA0,pA1,t,true,true,true);     WAIT_BAR(2); RESC(); ROT();
    STEP(pA0,pA1,pB0,pB1,t+1,true,true,true);   WAIT_BAR(2); RESC(); ROT();
  }
  #undef CMASK
  #define CMASK(P0,P1,t) do{int jb_=(t)-(NT-4); if(jb_>=0)cmask(P0,P1,jb_,qrel,hi);}while(0)
  #define ENDW(tt) do{ if((tt)+3<NT){WAIT_BAR(2);} else if((tt)+2<NT){WAIT_BAR(1);} else {WAIT_BAR(0);} }while(0)
  for(;t+1<NT;t+=2){
    STEP(pB0,pB1,pA0,pA1,t,(t+3<NT),(t+1<NT),(t+1<NT));       ENDW(t);   RESC(); ROT();
    STEP(pA0,pA1,pB0,pB1,t+1,(t+4<NT),(t+2<NT),(t+2<NT));     ENDW(t+1); RESC(); ROT();
  }
  STEP(pB0,pB1,pA0,pA1,NT-1,false,false,false); RESC();
  { float sacc=pB0[0]+pB0[1]; _Pragma("unroll") for(int r=2;r<16;++r)sacc+=pB0[r]; _Pragma("unroll") for(int r=0;r<16;++r)sacc+=pB1[r]; l_reg+=sacc;
    pw0=(u32x4){PKW(pB0,0),PKW(pB0,2),PKW(pB0,4),PKW(pB0,6)};pw1=(u32x4){PKW(pB0,8),PKW(pB0,10),PKW(pB0,12),PKW(pB0,14)};pw2=(u32x4){PKW(pB1,0),PKW(pB1,2),PKW(pB1,4),PKW(pB1,6)};pw3=(u32x4){PKW(pB1,8),PKW(pB1,10),PKW(pB1,12),PKW(pB1,14)};
    SBAR(); pv(o,vb0+sl_cur,PAF(0),PAF(1),PAF(2),PAF(3)); }
  #undef PKW
  #undef PAF
  #undef VFR
  #undef PIN
  #undef MX3
  #undef GAPA
  #undef GAPB
  #undef EX
  #undef VRD
  #undef KRD
  #undef STEP
  #undef ENDW
  {auto rr=__builtin_amdgcn_permlane32_swap(__float_as_uint(l_reg),__float_as_uint(l_reg),false,false);l_reg=__uint_as_float(rr[0])+__uint_as_float(rr[1]);}
  if(hi==0)wsf[32+r32]=l_reg;asm volatile("s_waitcnt lgkmcnt(0)":::"memory");
  float rli[16];
  #pragma unroll
  for(int r=0;r<16;++r)rli[r]=__builtin_amdgcn_rcpf(wsf[32+crow(r,hi)]);
  bf16*Ow=O+(rowbase+q0+wid*QBLK)*DM+h*D; const bf16*Gw=GT+(rowbase+q0+wid*QBLK)*DM+h*D;
  u32x4 ggs[4];
  _Pragma("unroll") for(int i=0;i<4;++i){const int row=i*8+(lane>>3),ch=lane&7; ggs[i]=*(const u32x4*)(Gw+(long)row*DM+ch*8);}
  { bf16*stg=(bf16*)(shm+LDS_OST)+wid*2048;
    #pragma unroll
    for(int r=0;r<16;++r){const int orow=crow(r,hi);
      #pragma unroll
      for(int d0=0;d0<2;++d0)stg[orow*64+d0*32+r32]=__float2bfloat16(o[d0][r]*rli[r]);}
    asm volatile("s_waitcnt lgkmcnt(0)":::"memory");
    #pragma unroll
    for(int i=0;i<4;++i){const int row=i*8+(lane>>3),ch=lane&7; u32x4 v=*(const u32x4*)(stg+row*64+ch*8); const u32x4 gg=ggs[i];
      #pragma unroll
      for(int e=0;e<4;++e){ const float olo=__uint_as_float(v[e]<<16),ohi=__uint_as_float(v[e]&0xffff0000u),glo=__uint_as_float(gg[e]<<16),ghi=__uint_as_float(gg[e]&0xffff0000u);
        const float slo=__builtin_amdgcn_rcpf(1.0f+__builtin_amdgcn_exp2f(-1.4426950408889634f*glo)),shi=__builtin_amdgcn_rcpf(1.0f+__builtin_amdgcn_exp2f(-1.4426950408889634f*ghi));
        v[e]=cvtpk_s(olo*slo,ohi*shi); }
      ATTN_STORE16(Ow+(long)row*DM+ch*8,v);} }
  asm volatile("s_waitcnt lgkmcnt(0)\n\ts_barrier":::"memory");
  #undef BIAS_INIT
  #undef DMA_K
  #undef DMA_V
  #undef CMASK
  #undef START
  #undef RESC
  #undef ROT
}
constexpr int ATTN_LDS_BYTES=LDS_BYTES;
struct AttnTensors { const bf16* Q; const bf16* K; const bf16* V; const bf16* G; const float* CK2; const unsigned* QN2; const unsigned* KN2; const unsigned* DG2; bf16* O; };
struct AttnUnit { int bh; int qb; };
struct StaticOrder {
  int vcu;
  __device__ __forceinline__ explicit StaticOrder(int grid,int block):vcu((block%8)*(grid/8)+block/8){}
  __device__ __forceinline__ bool next(int i,AttnUnit&u)const{ if(i>=8)return false; const int s=2*(i>>1)+(vcu&1); u.bh=vcu>>1; u.qb=(i&1)?s:15-s; return true; }
  __device__ __forceinline__ void a_ready(const AttnUnit&)const{}
  __device__ __forceinline__ void done(const AttnUnit&)const{}
};
struct QueueOrder {
  unsigned* ctr; volatile __attribute__((address_space(3))) unsigned* slot;
  __device__ __forceinline__ bool next(int,AttnUnit&u)const{
    if(threadIdx.x==0){ const unsigned v_=__hip_atomic_fetch_add(ctr,1u,__ATOMIC_RELAXED,__HIP_MEMORY_SCOPE_AGENT); *slot=v_; }
    asm volatile("s_waitcnt vmcnt(0) lgkmcnt(0)\n\ts_barrier":::"memory");
    const unsigned v=(unsigned)__builtin_amdgcn_readfirstlane(*slot);
    if(v>=(unsigned)(BATCH*NHEAD*NQB))return false; u.qb=NQB-1-(int)(v>>7); u.bh=(int)(v&127u); return true; }
  __device__ __forceinline__ void a_ready(const AttnUnit&)const{}
  __device__ __forceinline__ void done(const AttnUnit&)const{}
};
template<class Sched,int THRL=8> __device__ __forceinline__ void attn_phase(char*lds,const AttnTensors&T,const Sched&S){
  AttnUnit u;
  for(int i=0;S.next(i,u);++i){ S.a_ready(u); attn_unit<THRL>(u.bh/NHEAD,u.bh%NHEAD,u.qb,T.Q,T.K,T.V,T.G,T.CK2,T.QN2,T.KN2,T.DG2,T.O,lds); S.done(u); }
}
#undef SBAR
#undef WAIT_BAR
}
constexpr int NWAVES = 8;
#ifndef WGM_MLP1
#define WGM_MLP1 4
#endif
#ifndef WGM_MLP2
#define WGM_MLP2 4
#endif
#ifndef WGM_PROJ
#define WGM_PROJ 4
#endif
#ifndef WGM_GLU
#define WGM_GLU 4
#endif
#ifndef WGM_WO
#define WGM_WO 4
#endif
#ifndef NSUB
#define NSUB 8
#endif
constexpr int NB = 8, T = 4096, D = 1024, H = 16, HD = 64, FF = 4096, DEPTH = 4;
constexpr int M = NB * T;
constexpr int NPROJ = 4096;
constexpr int NPROJ_REAL = 4 * D + H;
constexpr float RMS_EPS = 1e-6f;
constexpr int S5G = 64, S5P = 64, S5H = 16, TC = 16, NSC = M / TC;
constexpr int S5KA = 384;

constexpr size_t MiB = 1u << 20;
constexpr size_t WS_CTL = 0, CTL_ZERO_BYTES = 1 * MiB;
constexpr size_t WS_WGLU = 1 * MiB;
constexpr size_t WS_WIN = 9 * MiB;
constexpr size_t WS_WOUT = 26 * MiB;
constexpr size_t WS_W1 = 30 * MiB;
constexpr size_t WS_W2 = 62 * MiB;
constexpr size_t WS_S5BM = 94 * MiB;
constexpr size_t WS_S5BS = 118 * MiB;
constexpr size_t WS_H16 = 126 * MiB;
constexpr size_t WS_XN = 190 * MiB;
#define WS_LF_OF(jf) (WS_S5BS + (size_t)(jf) * 4 * MiB)
constexpr size_t WS_CK2 = WS_XN + 2 * MiB;
constexpr size_t WS_BIG = 254 * MiB;
constexpr size_t WS_Q = WS_BIG, WS_K = WS_BIG + 64 * MiB, WS_V = WS_BIG + 128 * MiB, WS_GATE = WS_BIG + 192 * MiB;
constexpr size_t WS_AS5 = WS_BIG, WS_SL = WS_BIG + 96 * MiB, WS_G = WS_BIG + 160 * MiB;
constexpr size_t WS_END = 510 * MiB;
static_assert((size_t)64 * 2048 * 384 * 2 == 96 * MiB && (size_t)M * FF * 2 == 256 * MiB, "map");
constexpr int CW_WF = 163840;
constexpr int CW_ROWINV = 131072;
constexpr int CW_BAR = 4096;
constexpr int CW_QN2 = 32768, CW_KN2 = 40960, CW_QCTR = 45056, CW_DG2 = 49152;

constexpr int RING_OFF = 0, RING_BYTES = 131072;
constexpr int LDSCTL_OFF = RING_BYTES, MISC_OFF = LDSCTL_OFF + 320;
constexpr int LDS_BYTES = 147456;
static_assert(MISC_OFF + 128 <= LDS_BYTES, "LDS map");

struct Args { const float* in[16]; float* out; unsigned char* ws; };
#define GAS __attribute__((address_space(1)))
#define LAS __attribute__((address_space(3)))
typedef unsigned short bf16;
typedef unsigned v4u __attribute__((ext_vector_type(4)));
typedef float f32x4 __attribute__((ext_vector_type(4)));
typedef short bf16x8 __attribute__((ext_vector_type(8)));
typedef GAS unsigned gu32;
typedef GAS unsigned long long gu64;
#define RLX_AGENT __ATOMIC_RELAXED, __HIP_MEMORY_SCOPE_AGENT
#define LDS_WAIT() asm volatile("s_waitcnt lgkmcnt(0)" ::: "memory")
#define VM_WAIT() asm volatile("s_waitcnt vmcnt(0)" ::: "memory")
__device__ __forceinline__ unsigned long long rt() { return __builtin_amdgcn_s_memrealtime(); }
__device__ __forceinline__ unsigned f2bf(float f) { unsigned u = __builtin_bit_cast(unsigned, f); return (u + 0x7fffu + ((u >> 16) & 1u)) >> 16; }
__device__ __forceinline__ unsigned pk2(float lo, float hi) { unsigned r; asm("v_cvt_pk_bf16_f32 %0, %1, %2" : "=v"(r) : "v"(lo), "v"(hi)); return r; }

#define XB_TMO      128
#define XB_XCNT(j)  (256  + 64 * (j))
#define XB_XSUB(j)  (1280 + 64 * (j))
#define XB_XGEN(j)  (2304 + 64 * (j))
#define XB_TOP      3328
#define XB_TOPGEN   3392
#define XCD_BAR_WORDS 3456
#define XB_SPIN_CAP (1u << 18)

__device__ __forceinline__ unsigned xb_ld(unsigned* p)              { return __hip_atomic_load(p, __ATOMIC_RELAXED, __HIP_MEMORY_SCOPE_AGENT); }
__device__ __forceinline__ unsigned xb_add(unsigned* p, unsigned v) { return __hip_atomic_fetch_add(p, v, __ATOMIC_RELAXED, __HIP_MEMORY_SCOPE_AGENT); }
__device__ __forceinline__ unsigned xb_xcc_id() { return (unsigned)__builtin_amdgcn_s_getreg((3 << 11) | 20) & 0xFu; }
#define XB_SPIN(cond, bar) do { unsigned _sp = 0; while (cond) { __builtin_amdgcn_s_sleep(1); \
    if ((++_sp & 255u) == 0u) { if (xb_ld(&(bar)[XB_TMO])) break; if (_sp > XB_SPIN_CAP) { atomicAdd(&(bar)[XB_TMO], 1u); break; } } } } while (0)

struct XcdBarrier {
    unsigned* bar; unsigned x;
    volatile LAS unsigned* st;
};

__device__ __forceinline__ XcdBarrier xcd_barrier_post(unsigned* bar, volatile LAS unsigned* st) {
    XcdBarrier b; b.bar = bar; b.x = xb_xcc_id(); b.st = st;
    if (threadIdx.x == 0) (void)xb_add(&bar[XB_XCNT(b.x)], 1u);
    return b;
}
__device__ __forceinline__ void xcd_barrier_complete(unsigned* bar, unsigned x, unsigned& nloc, unsigned& nx) {
    const unsigned G = gridDim.x * gridDim.y * gridDim.z;
    unsigned sum, cnt, mine, sp = 0u;
    for (;;) {
        sum = 0u; cnt = 0u; mine = 0u;
#pragma unroll
        for (unsigned j = 0; j < 16; ++j) { const unsigned c = xb_ld(&bar[XB_XCNT(j)]); sum += c; cnt += (c > 0u) ? 1u : 0u; mine = (j == x) ? c : mine; }
        if (sum == G) break;
        __builtin_amdgcn_s_sleep(1);
        if ((++sp & 255u) == 0u) { if (xb_ld(&bar[XB_TMO])) break; if (sp > XB_SPIN_CAP) { atomicAdd(&bar[XB_TMO], 1u); break; } }
    }
    nloc = mine > 0u ? mine : 1u; nx = cnt > 0u ? cnt : 1u;
}

__device__ __forceinline__ void xcd_barrier(const XcdBarrier& b) {
    asm volatile("s_waitcnt vmcnt(0)" ::: "memory");
    __syncthreads();
    if (threadIdx.x == 0) {
        unsigned* bar = b.bar;
        __builtin_amdgcn_s_waitcnt(0);
        unsigned nloc = b.st[0], nx = b.st[1];
        if (nloc == 0u) { xcd_barrier_complete(bar, b.x, nloc, nx); b.st[0] = nloc; b.st[1] = nx; }
        const unsigned old = xb_add(&bar[XB_XSUB(b.x)], 1u);
        const unsigned gen = old / nloc;
        if (old + 1u == (gen + 1u) * nloc) {
            __builtin_amdgcn_fence(__ATOMIC_RELEASE, "agent");
            asm volatile("s_waitcnt vmcnt(0)" ::: "memory");
            const unsigned og = xb_add(&bar[XB_TOP], 1u);
            const unsigned tg = og / nx;
            if (og + 1u == (tg + 1u) * nx) xb_add(&bar[XB_TOPGEN], 1u);
            else XB_SPIN(xb_ld(&bar[XB_TOPGEN]) == tg, bar);
            __builtin_amdgcn_fence(__ATOMIC_ACQUIRE, "agent");
            xb_add(&bar[XB_XGEN(b.x)], 1u);
            asm volatile("s_waitcnt vmcnt(0)" ::: "memory");
        } else {
            XB_SPIN(xb_ld(&bar[XB_XGEN(b.x)]) == gen, bar);
            __builtin_amdgcn_fence(__ATOMIC_ACQUIRE, "agent");
            asm volatile("s_waitcnt vmcnt(0)" ::: "memory");
        }
    }
    __syncthreads();
}
typedef const __attribute__((address_space(4))) Args* KArgsP;
__device__ __forceinline__ KArgsP kargs() { KArgsP p = (KArgsP)__builtin_amdgcn_kernarg_segment_ptr(); asm volatile("" : "+s"(p)); return p; }
#define KA (kargs())

struct Frame {
    LAS unsigned char* lds;
    volatile LAS unsigned* MISC;
    gu32* ctl;
    int tid, lane, wave;
    int vcu, G;
};
__device__ __forceinline__ float wave_sum(float v) {
#pragma unroll
    for (int o = 1; o < 64; o <<= 1) v += __shfl_xor(v, o);
    return v;
}
__device__ __forceinline__ void p0_transpose_item(const float* W, int K, int N, bf16* WT, int k0, int n0, int dst_row0, const float* gain, LAS float* scr, int lane) {
    const int n = n0 + (lane & 31); const GAS float* Wg = (const GAS float*)W + (size_t)k0 * N + (n < N ? n : 0); const GAS float* gg = (const GAS float*)gain + k0;
#pragma unroll 1
    for (int h = 0; h < 2; ++h) {
        float wv[16]; const GAS float* Wh = Wg + (size_t)(32 * h + (lane >> 5)) * N;
#pragma unroll
        for (int i = 0; i < 16; ++i) wv[i] = Wh[(size_t)(2 * i) * N];
#pragma unroll
        for (int i = 0; i < 16; ++i) { const int kk = 32 * h + 2 * i + (lane >> 5); float w = (n < N) ? wv[i] : 0.f; if (gain) w *= gg[kk]; scr[kk * 33 + (lane & 31)] = w; }
    }
    LDS_WAIT(); asm volatile("" ::: "memory");
    const int c = lane & 7;
#pragma unroll
    for (int j = 0; j < 4; ++j) { const int nn = (lane >> 3) + 8 * j; const LAS float* s = scr + (8 * c) * 33 + nn;
        v4u o; o.x = pk2(s[0 * 33], s[1 * 33]); o.y = pk2(s[2 * 33], s[3 * 33]); o.z = pk2(s[4 * 33], s[5 * 33]); o.w = pk2(s[6 * 33], s[7 * 33]);
        *(GAS v4u*)(WT + (size_t)(dst_row0 + nn) * K + k0 + 8 * c) = o; }
    LDS_WAIT(); asm volatile("" ::: "memory");
}
__device__ __forceinline__ float cos_rev(float r) { return __builtin_amdgcn_cosf(r - floorf(r)); }
__device__ __forceinline__ float sin_rev(float r) { return __builtin_amdgcn_sinf(r - floorf(r)); }
constexpr float INV_2PI = 0.15915494309189535f;

__device__ __forceinline__ void s5_prep(Frame& F, int j, int g, int half) { const KArgsP a = KA;
    LAS float* L = (LAS float*)(F.lds + RING_OFF);
    LAS float* APr = L; LAS float* APi = L + 17 * 64; LAS float* BBr = L + 2 * 17 * 64; LAS float* BBi = BBr + 1024; LAS float* CCr = BBi + 1024; LAS float* CCi = CCr + 1024; LAS float* KK = CCi + 1024;
    const int tid = F.tid; const int jg = j * 64 + g;
    const float dt = __expf(a->in[4][jg]);
    for (int idx = tid; idx < 17 * 64; idx += 512) { const int jj = idx >> 6, p = idx & 63; const float are = a->in[2][jg * 64 + p], aim = a->in[3][jg * 64 + p];
        const float mag = __expf(are * dt * (float)jj), rev = aim * dt * (float)jj * INV_2PI; APr[idx] = mag * cos_rev(rev); APi[idx] = mag * sin_rev(rev); }
    for (int idx = tid; idx < 1024; idx += 512) { const int p = idx >> 4; const float are = a->in[2][jg * 64 + p], aim = a->in[3][jg * 64 + p];
        const float x = are * dt, rev = aim * dt * INV_2PI;
        const float em1 = x * (1.f + x * (0.5f + x * (0.16666667f + x * (0.041666668f + x * 0.008333334f))));
        const float c = cos_rev(rev), s = sin_rev(rev), sh = sin_rev(0.5f * rev);
        const float nr = em1 * c - 2.f * sh * sh, ni = (em1 + 1.f) * s;
        const float den = 1.f / (are * are + aim * aim), qr = (nr * are + ni * aim) * den, qi = (ni * are - nr * aim) * den;
        const float br = a->in[5][(size_t)jg * 1024 + idx], bi = a->in[6][(size_t)jg * 1024 + idx];
        BBr[idx] = qr * br - qi * bi; BBi[idx] = qr * bi + qi * br;
        CCr[idx] = a->in[7][(size_t)jg * 1024 + idx]; CCi[idx] = a->in[8][(size_t)jg * 1024 + idx]; }
    LDS_WAIT(); __syncthreads();
    { const int h = (tid >> 4) & 15, hp = tid & 15, j0 = (tid >> 8) * 8; float accj[8];
#pragma unroll
        for (int q = 0; q < 8; ++q) accj[q] = 0.f;
        for (int p = 0; p < 64; ++p) { const float cr = CCr[h * 64 + p], ci = CCi[h * 64 + p], br = BBr[p * 16 + hp], bi = BBi[p * 16 + hp];
            const float er = cr * br - ci * bi, ei = cr * bi + ci * br;
#pragma unroll
            for (int q = 0; q < 8; ++q) accj[q] += er * APr[(j0 + q) * 64 + p] - ei * APi[(j0 + q) * 64 + p]; }
#pragma unroll
        for (int q = 0; q < 8; ++q) KK[(j0 + q) * 256 + h * 16 + hp] = accj[q]; }
    LDS_WAIT(); __syncthreads();
    bf16* Bm = (bf16*)(a->ws + WS_S5BM) + (size_t)jg * 256 * 384;
    for (int pc = tid + half * 128 * 48; pc < (half + 1) * 128 * 48; pc += 512) { const int row = pc / 48, cp = pc % 48, t = row >> 4, h = row & 15, c0 = cp * 8; float v[8];
        if (c0 < 256) { const int s = c0 >> 4, hp0 = c0 & 15;
#pragma unroll
            for (int e = 0; e < 8; ++e) v[e] = (s <= t) ? KK[(t - s) * 256 + h * 16 + hp0 + e] : 0.f;
        } else { const int pp = c0 - 256;
#pragma unroll
            for (int e = 0; e < 8; ++e) { const int p = (pp + e) & 63; const float cr = CCr[h * 64 + p], ci = CCi[h * 64 + p], ar = APr[(t + 1) * 64 + p], ai = APi[(t + 1) * 64 + p];
                v[e] = (pp < 64) ? (cr * ar - ci * ai) : -(cr * ai + ci * ar); } }
        v4u o; o.x = pk2(v[0], v[1]); o.y = pk2(v[2], v[3]); o.z = pk2(v[4], v[5]); o.w = pk2(v[6], v[7]);
        *(GAS v4u*)(Bm + (size_t)row * 384 + c0) = o; }
    bf16* Bs = (bf16*)(a->ws + WS_S5BS) + (size_t)jg * 128 * 256;
    for (int pc = tid + half * 64 * 32; pc < (half + 1) * 64 * 32; pc += 512) { const int row = pc >> 5, cp = pc & 31, c0 = cp * 8, s = c0 >> 4, hp0 = c0 & 15; float v[8];
        if (row < 128) { const int p = row & 63; const float ar = APr[(15 - s) * 64 + p], ai = APi[(15 - s) * 64 + p];
#pragma unroll
            for (int e = 0; e < 8; ++e) { const float br = BBr[p * 16 + hp0 + e], bi = BBi[p * 16 + hp0 + e]; v[e] = (row < 64) ? (ar * br - ai * bi) : (ar * bi + ai * br); }
        } else {
#pragma unroll
            for (int e = 0; e < 8; ++e) v[e] = 0.f; }
        v4u o; o.x = pk2(v[0], v[1]); o.y = pk2(v[2], v[3]); o.z = pk2(v[4], v[5]); o.w = pk2(v[6], v[7]);
        *(GAS v4u*)(Bs + (size_t)row * 256 + c0) = o; }
    LDS_WAIT(); __syncthreads();
}

__device__ __forceinline__ void bf8_to_f32(const v4u w, float (&o)[8]) {
#pragma unroll
    for (int e = 0; e < 4; ++e) { o[2 * e] = __uint_as_float(w[e] << 16); o[2 * e + 1] = __uint_as_float(w[e] & 0xffff0000u); } }
__device__ __forceinline__ v4u f32_to_bf8(const float (&x)[8]) { v4u o; o.x = pk2(x[0], x[1]); o.y = pk2(x[2], x[3]); o.z = pk2(x[4], x[5]); o.w = pk2(x[6], x[7]); return o; }
__device__ __forceinline__ void norm_pass(Frame& F, const float* hsrc32, bf16* H16, const bf16* mix, const float* gpost, int premode, const float* gpre, bf16* AS5, float* out32, float* rowinv, bool wr_h, const bf16* wf = nullptr, const float* bfv = nullptr, float* LF = nullptr) {
    const int gw = F.vcu * NWAVES + F.wave, NGW = F.G * NWAVES; int lane_ = F.lane; asm volatile("" : "+v"(lane_)); const int lane = lane_;
    f32x4 gpo[2][2], gpr[2][2];
#pragma unroll
    for (int j = 0; j < 2; ++j) { const f32x4 z = {0.f, 0.f, 0.f, 0.f}; gpo[j][0] = z; gpo[j][1] = z; gpr[j][0] = z; gpr[j][1] = z;
        if (mix) { const GAS f32x4* gp = (const GAS f32x4*)(gpost + 8 * lane + 512 * j); gpo[j][0] = gp[0]; gpo[j][1] = gp[1]; }
        if (premode == 2) { const GAS f32x4* gp = (const GAS f32x4*)(gpre + 8 * lane + 512 * j); gpr[j][0] = gp[0]; gpr[j][1] = gp[1]; } }
    v4u wfr[16][2];
#pragma unroll
    for (int hh = 0; hh < 16; ++hh)
#pragma unroll
        for (int j = 0; j < 2; ++j) { const v4u z = {0u, 0u, 0u, 0u}; wfr[hh][j] = wf ? *(const GAS v4u*)(wf + (size_t)hh * D + 8 * lane + 512 * j) : z; }
    for (int m0 = gw; m0 < M; m0 += 2 * NGW) {
        float v[2][2][8]; v4u mw[2][2];
#pragma unroll
        for (int r = 0; r < 2; ++r) { const int m = m0 + r * NGW;
            if (hsrc32) {
#pragma unroll
                for (int j = 0; j < 2; ++j) { const GAS f32x4* xr = (const GAS f32x4*)(hsrc32 + (size_t)m * D + 8 * lane + 512 * j); const f32x4 a = xr[0], b = xr[1];
                    v[r][j][0] = a.x; v[r][j][1] = a.y; v[r][j][2] = a.z; v[r][j][3] = a.w; v[r][j][4] = b.x; v[r][j][5] = b.y; v[r][j][6] = b.z; v[r][j][7] = b.w; }
            } else {
#pragma unroll
                for (int j = 0; j < 2; ++j) { const v4u w = *(const GAS v4u*)(H16 + (size_t)m * D + 8 * lane + 512 * j); bf8_to_f32(w, v[r][j]); } }
            if (mix) {
#pragma unroll
                for (int j = 0; j < 2; ++j) mw[r][j] = *(const GAS v4u*)(mix + (size_t)m * D + 8 * lane + 512 * j); } }
#pragma unroll
        for (int r = 0; r < 2; ++r) { const int m = m0 + r * NGW;
            if (mix) {
                float x[2][8]; float s = 0.f;
#pragma unroll
                for (int j = 0; j < 2; ++j) { bf8_to_f32(mw[r][j], x[j]);
#pragma unroll
                    for (int e = 0; e < 8; ++e) s += x[j][e] * x[j][e]; }
                const float rr = 1.f / sqrtf(wave_sum(s) * (1.f / D) + RMS_EPS);
#pragma unroll
                for (int j = 0; j < 2; ++j) { const f32x4 ga = gpo[j][0], gb = gpo[j][1];
                    v[r][j][0] += x[j][0] * rr * ga.x; v[r][j][1] += x[j][1] * rr * ga.y; v[r][j][2] += x[j][2] * rr * ga.z; v[r][j][3] += x[j][3] * rr * ga.w;
                    v[r][j][4] += x[j][4] * rr * gb.x; v[r][j][5] += x[j][5] * rr * gb.y; v[r][j][6] += x[j][6] * rr * gb.z; v[r][j][7] += x[j][7] * rr * gb.w; }
            }
            if (premode == 0) {
#pragma unroll
                for (int j = 0; j < 2; ++j) { GAS f32x4* orow = (GAS f32x4*)(out32 + (size_t)m * D + 8 * lane + 512 * j);
                    orow[0] = (f32x4){v[r][j][0], v[r][j][1], v[r][j][2], v[r][j][3]}; orow[1] = (f32x4){v[r][j][4], v[r][j][5], v[r][j][6], v[r][j][7]}; }
            } else {
                v4u hpk[2];
#pragma unroll
                for (int j = 0; j < 2; ++j) hpk[j] = f32_to_bf8(v[r][j]);
                if (wr_h) {
#pragma unroll
                    for (int j = 0; j < 2; ++j) *(GAS v4u*)(H16 + (size_t)m * D + 8 * lane + 512 * j) = hpk[j]; }
                float s2 = 0.f;
#pragma unroll
                for (int j = 0; j < 2; ++j)
#pragma unroll
                    for (int e = 0; e < 8; ++e) s2 += v[r][j][e] * v[r][j][e];
                const float inv = 1.f / sqrtf(wave_sum(s2) * (1.f / D) + RMS_EPS);
                if (premode == 1) { if (lane == 0) rowinv[m] = inv;
                    if (wf) {
                        typedef __bf16 bf16x2_t __attribute__((ext_vector_type(2)));
                        const unsigned hw[8] = {hpk[0].x, hpk[0].y, hpk[0].z, hpk[0].w, hpk[1].x, hpk[1].y, hpk[1].z, hpk[1].w};
                        float q8[8], q4[4], q2[2], q1;
                        { const bool up = (lane & 32) != 0;
#pragma unroll
                          for (int i = 0; i < 8; ++i) { float pa = 0.f, pb = 0.f;
                              const unsigned wa[8] = {wfr[i][0].x, wfr[i][0].y, wfr[i][0].z, wfr[i][0].w, wfr[i][1].x, wfr[i][1].y, wfr[i][1].z, wfr[i][1].w};
                              const unsigned wb[8] = {wfr[i + 8][0].x, wfr[i + 8][0].y, wfr[i + 8][0].z, wfr[i + 8][0].w, wfr[i + 8][1].x, wfr[i + 8][1].y, wfr[i + 8][1].z, wfr[i + 8][1].w};
#pragma unroll
                              for (int e = 0; e < 8; ++e) { pa = __builtin_amdgcn_fdot2_f32_bf16(__builtin_bit_cast(bf16x2_t, hw[e]), __builtin_bit_cast(bf16x2_t, wa[e]), pa, false);
                                                            pb = __builtin_amdgcn_fdot2_f32_bf16(__builtin_bit_cast(bf16x2_t, hw[e]), __builtin_bit_cast(bf16x2_t, wb[e]), pb, false); }
                              const float keep = up ? pb : pa, send = up ? pa : pb; q8[i] = keep + __shfl_xor(send, 32); } }
                        { const bool up = (lane & 16) != 0;
#pragma unroll
                          for (int i = 0; i < 4; ++i) { const float keep = up ? q8[i + 4] : q8[i], send = up ? q8[i] : q8[i + 4]; q4[i] = keep + __shfl_xor(send, 16); } }
                        { const bool up = (lane & 8) != 0;
#pragma unroll
                          for (int i = 0; i < 2; ++i) { const float keep = up ? q4[i + 2] : q4[i], send = up ? q4[i] : q4[i + 2]; q2[i] = keep + __shfl_xor(send, 8); } }
                        { const bool up = (lane & 4) != 0; const float keep = up ? q2[1] : q2[0], send = up ? q2[0] : q2[1]; q1 = keep + __shfl_xor(send, 4); }
                        q1 += __shfl_xor(q1, 2); q1 += __shfl_xor(q1, 1);
                        if ((lane & 3) == 0) { const int hh = lane >> 2; const float x = q1 * inv + bfv[hh]; LF[(size_t)m * 16 + hh] = fminf(x, 0.f) - __logf(1.0f + __expf(-fabsf(x))); }
                    } }
                else {
                    const int sc = m >> 4, t = m & 15;
#pragma unroll
                    for (int j = 0; j < 2; ++j) { const f32x4 ga = gpr[j][0], gb = gpr[j][1]; float w[8];
                        w[0] = v[r][j][0] * inv * ga.x; w[1] = v[r][j][1] * inv * ga.y; w[2] = v[r][j][2] * inv * ga.z; w[3] = v[r][j][3] * inv * ga.w;
                        w[4] = v[r][j][4] * inv * gb.x; w[5] = v[r][j][5] * inv * gb.y; w[6] = v[r][j][6] * inv * gb.z; w[7] = v[r][j][7] * inv * gb.w;
                        const int g = (lane >> 1) + 32 * j;
                        *(GAS v4u*)(AS5 + ((size_t)g * NSC + sc) * S5KA + t * 16 + 8 * (lane & 1)) = f32_to_bf8(w); }
                }
            }
        }
    }
}

__device__ __forceinline__ void s5_carry(Frame& F, int j) { const KArgsP a = KA;
    if (F.wave < 2) {
        int p_ = F.lane; asm volatile("" : "+v"(p_)); const int item = F.wave * 256 + (int)blockIdx.x; const int g = item >> 3, b = item & 7, p = p_; const int jg = j * 64 + g;
        const float dt = __expf(a->in[4][jg]); const float are = a->in[2][jg * 64 + p], aim = a->in[3][jg * 64 + p];
        const float mag = __expf(are * dt * 16.f), rev = aim * dt * 16.f * INV_2PI; const float ar = mag * cos_rev(rev), ai = mag * sin_rev(rev);
        const float* SL = (const float*)(a->ws + WS_SL) + ((size_t)g * NSC + b * 256) * 128;
        bf16* AS = (bf16*)(a->ws + WS_AS5) + ((size_t)g * NSC + b * 256) * S5KA + 256;
        float xr = 0.f, xi = 0.f;
#pragma unroll 16
        for (int sc = 0; sc < 256; ++sc) {
            const float lr = SL[(size_t)sc * 128 + p], li = SL[(size_t)sc * 128 + 64 + p];
            AS[(size_t)sc * S5KA + p] = (bf16)f2bf(xr); AS[(size_t)sc * S5KA + 64 + p] = (bf16)f2bf(xi);
            const float nr = ar * xr - ai * xi + lr, ni = ar * xi + ai * xr + li; xr = nr; xi = ni;
        }
    }
}

__device__ __forceinline__ void fox_cumsum(Frame& F, int j) { const KArgsP a = KA;
    if (blockIdx.x < NB * H) {
        int tid_ = F.tid; asm volatile("" : "+v"(tid_)); const int bh = blockIdx.x, b = bh >> 4, h = bh & 15, tid = tid_; const int lane_ = tid & 63;
        const float* LF = (const float*)(a->ws + WS_LF_OF(j)) + ((size_t)b * T + 8 * tid) * 16 + h;
        float v[8]; float run = 0.f;
#pragma unroll
        for (int i = 0; i < 8; ++i) { run += LF[i * 16]; v[i] = run; }
        float x = run;
#pragma unroll
        for (int o = 1; o < 64; o <<= 1) { const float tt = __shfl_up(x, o); if (lane_ >= o) x += tt; }
        LAS float* wt = (LAS float*)(F.lds + RING_OFF);
        if (lane_ == 63) wt[F.wave] = x;
        LDS_WAIT(); __syncthreads();
        float pre = x - run;
        for (int w = 0; w < F.wave; ++w) pre += wt[w];
        float* o = (float*)(a->ws + WS_CK2) + (size_t)bh * T + 8 * tid;
        const float L2E = 1.4426950408889634f;
        *(f32x4*)o = (f32x4){(pre + v[0]) * L2E, (pre + v[1]) * L2E, (pre + v[2]) * L2E, (pre + v[3]) * L2E};
        *(f32x4*)(o + 4) = (f32x4){(pre + v[4]) * L2E, (pre + v[5]) * L2E, (pre + v[6]) * L2E, (pre + v[7]) * L2E};
        LDS_WAIT(); __syncthreads();
    }
}

__device__ __forceinline__ void fox_norms(Frame& F, int j) {
    const KArgsP a = KA; int lane_ = F.lane; asm volatile("" : "+v"(lane_)); const int lane = lane_;
    const int gw = F.vcu * NWAVES + F.wave, NGW = F.G * NWAVES;
    for (int task = gw; task < M / 16; task += NGW) {
        const int m0 = task * 16; float qmx = 0.f, kmx = 0.f, dmx = 0.f;
#pragma unroll 4
        for (int r = 0; r < 16; ++r) {
            const v4u* qp = (const v4u*)((const bf16*)(a->ws + WS_Q) + (size_t)(m0 + r) * D + 16 * lane); const v4u* kp = (const v4u*)((const bf16*)(a->ws + WS_K) + (size_t)(m0 + r) * D + 16 * lane);
            const v4u q0 = qp[0], q1 = qp[1], k0 = kp[0], k1 = kp[1]; float sq = 0.f, sk = 0.f, sd = 0.f;
#pragma unroll
            for (int e = 0; e < 4; ++e) { float x;
                float y;
                x = __uint_as_float(q0[e] << 16); y = __uint_as_float(k0[e] << 16); sq += x * x; sk += y * y; sd += x * y;
                x = __uint_as_float(q0[e] & 0xffff0000u); y = __uint_as_float(k0[e] & 0xffff0000u); sq += x * x; sk += y * y; sd += x * y;
                x = __uint_as_float(q1[e] << 16); y = __uint_as_float(k1[e] << 16); sq += x * x; sk += y * y; sd += x * y;
                x = __uint_as_float(q1[e] & 0xffff0000u); y = __uint_as_float(k1[e] & 0xffff0000u); sq += x * x; sk += y * y; sd += x * y; }
            sq += __shfl_xor(sq, 1); sq += __shfl_xor(sq, 2); sk += __shfl_xor(sk, 1); sk += __shfl_xor(sk, 2); sd += __shfl_xor(sd, 1); sd += __shfl_xor(sd, 2);
            qmx = fmaxf(qmx, sq); kmx = fmaxf(kmx, sk); dmx = fmaxf(dmx, -sd);
        }
        if ((lane & 3) == 0) { const int b = m0 >> 12, qb = (m0 & 4095) >> 8, bh = b * 16 + (lane >> 2);
            __hip_atomic_fetch_max((unsigned*)(F.ctl + CW_QN2) + j * 2048 + bh * 16 + qb, __float_as_uint(qmx * 1.02f), RLX_AGENT);
            __hip_atomic_fetch_max((unsigned*)(F.ctl + CW_KN2) + j * 128 + bh, __float_as_uint(kmx * 1.02f), RLX_AGENT);
            __hip_atomic_fetch_max((unsigned*)(F.ctl + CW_DG2) + j * 2048 + bh * 16 + qb, __float_as_uint(dmx * 1.01f + 0.05f), RLX_AGENT); }
    }
}

__device__ __forceinline__ void p0_prologue(Frame& F, bool do_w, bool do_n) {
    if (do_w) s5_prep(F, ((int)blockIdx.x >> 6) & 1, (int)blockIdx.x & 63, (int)blockIdx.x >> 7);
    const KArgsP a = KA;
    const float* gains = a->in[1];
    if (do_w) {
    LAS float* scr = (LAS float*)(F.lds + RING_OFF + F.wave * 16384);
    const int gw = F.vcu * NWAVES + F.wave, NGW = F.G * NWAVES;
    constexpr int I_GLU = 16 * 64, I_WIN = 16 * 128, I_WOUT = 16 * 32, I_W1 = 16 * 128, I_W2 = 64 * 32, I_Z = 16;
    constexpr int NITEMS = 2 * I_GLU + 2 * I_WIN + 2 * I_WOUT + 4 * I_W1 + 4 * I_W2 + 2 * I_Z;
    for (int it = gw; it < NITEMS; it += NGW) {
        int r = it;
        if (r < 2 * I_GLU) { const int j = r / I_GLU; r -= j * I_GLU; const int kb = r >> 6, nb = r & 63, n0 = nb * 32;
            const int dst = (n0 < 1024) ? ((n0 >> 7) * 256 + (n0 & 127)) : ((((n0 - 1024) >> 7) * 256) + 128 + ((n0 - 1024) & 127));
            p0_transpose_item(a->in[10] + (size_t)j * 1024 * 2048, 1024, 2048, (bf16*)(a->ws + WS_WGLU) + (size_t)j * 2048 * 1024, kb * 64, n0, dst, nullptr, scr, F.lane); continue; }
        r -= 2 * I_GLU;
        if (r < 2 * I_WIN) { const int j = r / I_WIN; r -= j * I_WIN; const int kb = r >> 7, nb = r & 127, n0 = nb * 32;
            p0_transpose_item(a->in[11] + (size_t)j * 1024 * NPROJ_REAL, 1024, NPROJ_REAL, (bf16*)(a->ws + WS_WIN) + (size_t)j * NPROJ * 1024, kb * 64, n0, n0, gains + (size_t)(2 * j + 1) * 4 * D, scr, F.lane); continue; }
        r -= 2 * I_WIN;
        if (r < 2 * I_WOUT) { const int j = r / I_WOUT; r -= j * I_WOUT; const int kb = r >> 5, nb = r & 31, n0 = nb * 32;
            p0_transpose_item(a->in[13] + (size_t)j * 1024 * 1024, 1024, 1024, (bf16*)(a->ws + WS_WOUT) + (size_t)j * 1024 * 1024, kb * 64, n0, n0, nullptr, scr, F.lane); continue; }
        r -= 2 * I_WOUT;
        if (r < 4 * I_W1) { const int i = r / I_W1; r -= i * I_W1; const int kb = r >> 7, nb = r & 127, n0 = nb * 32;
            p0_transpose_item(a->in[14] + (size_t)i * 1024 * 4096, 1024, 4096, (bf16*)(a->ws + WS_W1) + (size_t)i * 4096 * 1024, kb * 64, n0, n0, gains + (size_t)i * 4 * D + 2 * D, scr, F.lane); continue; }
        r -= 4 * I_W1;
        if (r < 4 * I_W2) { const int i = r / I_W2; r -= i * I_W2; const int kb = r >> 5, nb = r & 31, n0 = nb * 32;
            p0_transpose_item(a->in[15] + (size_t)i * 4096 * 1024, 4096, 1024, (bf16*)(a->ws + WS_W2) + (size_t)i * 1024 * 4096, kb * 64, n0, n0, nullptr, scr, F.lane); continue; }
        r -= 4 * I_W2;
        { const int j = r / I_Z, hh = r % I_Z;
            const GAS float* wsrc = (const GAS float*)(a->in[11] + (size_t)j * 1024 * NPROJ_REAL) + 4096 + hh; const GAS float* gsrc = (const GAS float*)(gains + (size_t)(2 * j + 1) * 4 * D);
            float w[16];
#pragma unroll
            for (int e = 0; e < 16; ++e) w[e] = wsrc[(size_t)(16 * F.lane + e) * NPROJ_REAL] * gsrc[16 * F.lane + e];
            GAS v4u* dst = (GAS v4u*)((bf16*)(F.ctl + CW_WF) + ((size_t)j * 16 + hh) * 1024 + 16 * F.lane);
            v4u o0, o1; o0.x = pk2(w[0], w[1]); o0.y = pk2(w[2], w[3]); o0.z = pk2(w[4], w[5]); o0.w = pk2(w[6], w[7]); o1.x = pk2(w[8], w[9]); o1.y = pk2(w[10], w[11]); o1.z = pk2(w[12], w[13]); o1.w = pk2(w[14], w[15]);
            dst[0] = o0; dst[1] = o1; }
    }
    }
    if (do_n) norm_pass(F, a->in[0], nullptr, nullptr, nullptr, 2, gains, (bf16*)(a->ws + WS_AS5), nullptr, nullptr, false);
}

__global__ void __launch_bounds__(NWAVES * 64, 2) mk_fwd(Args args_unused) {
    extern __shared__ __attribute__((aligned(16))) unsigned char lds[];
    Frame F;
    F.lds = (LAS unsigned char*)lds;
    F.MISC = (volatile LAS unsigned*)(F.lds + MISC_OFF);
    F.tid = threadIdx.x; F.lane = F.tid & 63; F.wave = __builtin_amdgcn_readfirstlane(F.tid >> 6);
    F.G = gridDim.x; { const int bx = blockIdx.x; F.vcu = (F.G % 8 == 0) ? (bx % 8) * (F.G / 8) + bx / 8 : bx; }
    F.ctl = (gu32*)(KA->ws + WS_CTL);
    for (int u = F.tid; u < (LDS_BYTES - LDSCTL_OFF) / 4; u += NWAVES * 64) ((LAS unsigned*)(F.lds + LDSCTL_OFF))[u] = 0u;
    __syncthreads();
    XcdBarrier bar = xcd_barrier_post((unsigned*)(F.ctl + CW_BAR), F.MISC + 8);
#define GRID_BAR() do { XcdBarrier b_ = bar; asm volatile("" : "+s"(b_.bar), "+s"(b_.x)); xcd_barrier(b_); } while (0)
#define WSP(T_, off) ((T_*)(KA->ws + (off)))
#define GAINS(i_, k_) (KA->in[1] + (size_t)(i_) * 4 * D + (size_t)(k_) * D)

#ifndef SKIP_PRO
    p0_prologue(F, true, true);
#ifdef PROBE_PRO_W
    GRID_BAR(); p0_prologue(F, true, false);
#endif
#ifdef PROBE_PRO_N
    GRID_BAR(); p0_prologue(F, false, true);
#endif
#endif
    if (F.G != 256) cooperative_groups::this_grid().sync();
    GRID_BAR();
#ifdef PROBE_BAR
    for (int pb = 0; pb < 20; ++pb) GRID_BAR();
#endif
#ifdef PROBE_CGSYNC
    for (int pb = 0; pb < 20; ++pb) cooperative_groups::this_grid().sync();
#endif
#if NSUB == 0
    norm_pass(F, KA->in[0], nullptr, nullptr, nullptr, 0, nullptr, nullptr, KA->out, nullptr, false);
#else
    for (int i = 0; i < DEPTH; ++i) {
        if (2 * i >= NSUB) break;
        const int j = i >> 1;
        if ((i & 1) == 0) {
#ifndef SKIP_S5LOC
            for (int k = 0; k < 2; ++k) {
              pg8::Gemm g{WSP(const bf16, WS_AS5), WSP(const bf16, WS_S5BS) + (size_t)j * 64 * 128 * 256, 64 * NSC, 256, 256, S5KA, 256, 128}; const pg8::S5OneOrder S{256 * k + F.vcu};
              pg8::EpiS5LocCarry E{WSP(bf16, WS_AS5), KA->in[2] + (size_t)j * 4096, KA->in[3] + (size_t)j * 4096, KA->in[4] + (size_t)j * 64};
              pg8::gemm_phase<pg8::EpiS5LocCarry, pg8::S5OneOrder, false, true>(F.lds + RING_OFF, g, S, E); }
#endif
            asm volatile("s_waitcnt vmcnt(0)" ::: "memory"); __syncthreads();
#ifndef SKIP_S5MAIN
            { pg8::Gemm g{WSP(const bf16, WS_AS5), WSP(const bf16, WS_S5BM) + (size_t)j * 64 * 256 * 384, 64 * NSC, 256, 384, S5KA, 384, 256}; pg8::S5Order S; S.init(F.G, F.vcu);
              pg8::EpiS5Main E{WSP(bf16, WS_G), WSP(const bf16, WS_AS5), KA->in[9] + (size_t)j * D};
              pg8::gemm_phase<pg8::EpiS5Main, pg8::S5Order, true, true>(F.lds + RING_OFF, g, S, E); }
#ifdef PROBE_S5MAIN
            GRID_BAR();
            { pg8::Gemm g{WSP(const bf16, WS_AS5), WSP(const bf16, WS_S5BM) + (size_t)j * 64 * 256 * 384, 64 * NSC, 256, 384, S5KA, 384, 256}; pg8::S5Order S; S.init(F.G, F.vcu);
              pg8::EpiS5Main E{WSP(bf16, WS_G), WSP(const bf16, WS_AS5), KA->in[9] + (size_t)j * D};
              pg8::gemm_phase<pg8::EpiS5Main, pg8::S5Order, true, true>(F.lds + RING_OFF, g, S, E); }
#endif
#endif
            GRID_BAR();
#ifndef SKIP_GLU
            { pg8::Gemm g{WSP(const bf16, WS_G), WSP(const bf16, WS_WGLU) + (size_t)j * 2048 * 1024, M, 2048, D, D, D, 256}; pg8::StaticOrder S; S.init(M, 2048, F.G, (int)blockIdx.x, WGM_GLU);
              pg8::EpiGLU E{WSP(bf16, WS_XN), D};
              pg8::gemm_phase<pg8::EpiGLU, pg8::StaticOrder, true, true>(F.lds + RING_OFF, g, S, E); }
#ifdef PROBE_GLU
            GRID_BAR();
            { pg8::Gemm g{WSP(const bf16, WS_G), WSP(const bf16, WS_WGLU) + (size_t)j * 2048 * 1024, M, 2048, D, D, D, 256}; pg8::StaticOrder S; S.init(M, 2048, F.G, (int)blockIdx.x, WGM_GLU);
              pg8::EpiGLU E{WSP(bf16, WS_XN), D};
              pg8::gemm_phase<pg8::EpiGLU, pg8::StaticOrder, true, true>(F.lds + RING_OFF, g, S, E); }
#endif
#endif
        } else {
#ifndef SKIP_PROJ
            { pg8::Gemm g{WSP(const bf16, WS_H16), WSP(const bf16, WS_WIN) + (size_t)j * NPROJ * 1024, M, NPROJ, D, D, D, 256}; pg8::StaticOrder S; S.init(M, NPROJ, F.G, (int)blockIdx.x, WGM_PROJ);
              pg8::EpiProj E{WSP(bf16, WS_Q), (size_t)M * D, attn_body::C2, (const float*)(F.ctl + CW_ROWINV)};
              pg8::gemm_phase<pg8::EpiProj, pg8::StaticOrder, true, true>(F.lds + RING_OFF, g, S, E); }
#ifdef PROBE_PROJ
            GRID_BAR();
            { pg8::Gemm g{WSP(const bf16, WS_H16), WSP(const bf16, WS_WIN) + (size_t)j * NPROJ * 1024, M, NPROJ, D, D, D, 256}; pg8::StaticOrder S; S.init(M, NPROJ, F.G, (int)blockIdx.x, WGM_PROJ);
              pg8::EpiProj E{WSP(bf16, WS_Q), (size_t)M * D, attn_body::C2, (const float*)(F.ctl + CW_ROWINV)};
              pg8::gemm_phase<pg8::EpiProj, pg8::StaticOrder, true, true>(F.lds + RING_OFF, g, S, E); }
#endif
#endif
            GRID_BAR();
#ifndef SKIP_CUMSUM
            fox_cumsum(F, j);
            fox_norms(F, j);
#endif
            GRID_BAR();
#ifndef SKIP_ATTN
            { const attn_body::AttnTensors AT{WSP(const attn_body::bf16, WS_Q), WSP(const attn_body::bf16, WS_K), WSP(const attn_body::bf16, WS_V), WSP(const attn_body::bf16, WS_GATE), WSP(const float, WS_CK2), (const unsigned*)(F.ctl + CW_QN2) + j * 2048, (const unsigned*)(F.ctl + CW_KN2) + j * 128, (const unsigned*)(F.ctl + CW_DG2) + j * 2048, WSP(attn_body::bf16, WS_Q)};
              const attn_body::QueueOrder S{(unsigned*)(F.ctl + CW_QCTR) + 64 * j, F.MISC + 16};
              attn_body::attn_phase<attn_body::QueueOrder>((char*)lds + RING_OFF, AT, S); }
#endif
            GRID_BAR();
#ifndef SKIP_WO
            { pg8::Gemm g{WSP(const bf16, WS_Q), WSP(const bf16, WS_WOUT) + (size_t)j * 1024 * 1024, M, D, D, D, D, 256}; pg8::StaticOrder S; S.init(M, D, F.G, (int)blockIdx.x, WGM_WO);
              pg8::EpiPlain E{WSP(bf16, WS_XN), D};
              pg8::gemm_phase<pg8::EpiPlain, pg8::StaticOrder, true, true>(F.lds + RING_OFF, g, S, E); }
#ifdef PROBE_WO
            GRID_BAR();
            { pg8::Gemm g{WSP(const bf16, WS_Q), WSP(const bf16, WS_WOUT) + (size_t)j * 1024 * 1024, M, D, D, D, D, 256}; pg8::StaticOrder S; S.init(M, D, F.G, (int)blockIdx.x, WGM_WO);
              pg8::EpiPlain E{WSP(bf16, WS_XN), D};
              pg8::gemm_phase<pg8::EpiPlain, pg8::StaticOrder, true, true>(F.lds + RING_OFF, g, S, E); }
#endif
#endif
        }
        GRID_BAR();
        const bool lastsub = (2 * i + 1 >= NSUB);
        norm_pass(F, i == 0 ? KA->in[0] : (const float*)nullptr, WSP(bf16, WS_H16), WSP(const bf16, WS_XN), GAINS(i, 1), lastsub ? 0 : 1, nullptr, nullptr, KA->out, (float*)(F.ctl + CW_ROWINV), true);
        if (lastsub) break;
        GRID_BAR();
#ifndef SKIP_MLP
        { pg8::Gemm g{WSP(const bf16, WS_H16), WSP(const bf16, WS_W1) + (size_t)i * 4096 * 1024, M, FF, D, D, D, 256}; pg8::StaticOrder S; S.init(M, FF, F.G, (int)blockIdx.x, WGM_MLP1);
          pg8::EpiRelu2 E{WSP(bf16, WS_BIG), FF, (const float*)(F.ctl + CW_ROWINV)};
          pg8::gemm_phase<pg8::EpiRelu2, pg8::StaticOrder, true, true>(F.lds + RING_OFF, g, S, E); }
#ifdef PROBE_MLP1
            GRID_BAR();
        { pg8::Gemm g{WSP(const bf16, WS_H16), WSP(const bf16, WS_W1) + (size_t)i * 4096 * 1024, M, FF, D, D, D, 256}; pg8::StaticOrder S; S.init(M, FF, F.G, (int)blockIdx.x, WGM_MLP1);
          pg8::EpiRelu2 E{WSP(bf16, WS_BIG), FF, (const float*)(F.ctl + CW_ROWINV)};
          pg8::gemm_phase<pg8::EpiRelu2, pg8::StaticOrder, true, true>(F.lds + RING_OFF, g, S, E); }
#endif
        GRID_BAR();
        { pg8::Gemm g{WSP(const bf16, WS_BIG), WSP(const bf16, WS_W2) + (size_t)i * 1024 * 4096, M, D, FF, FF, FF, 256}; pg8::StaticOrder S; S.init(M, D, F.G, (int)blockIdx.x, WGM_MLP2);
          pg8::EpiPlain E{WSP(bf16, WS_XN), D};
          pg8::gemm_phase<pg8::EpiPlain, pg8::StaticOrder, true, true>(F.lds + RING_OFF, g, S, E); }
#ifdef PROBE_MLP2
            GRID_BAR();
        { pg8::Gemm g{WSP(const bf16, WS_BIG), WSP(const bf16, WS_W2) + (size_t)i * 1024 * 4096, M, D, FF, FF, FF, 256}; pg8::StaticOrder S; S.init(M, D, F.G, (int)blockIdx.x, WGM_MLP2);
          pg8::EpiPlain E{WSP(bf16, WS_XN), D};
          pg8::gemm_phase<pg8::EpiPlain, pg8::StaticOrder, true, true>(F.lds + RING_OFF, g, S, E); }
#endif
#endif
        GRID_BAR();
        const bool fin = (2 * i + 2 >= NSUB) || (i == DEPTH - 1);
        const int premode = fin ? 0 : (((i + 1) & 1) == 0 ? 2 : 1);
        if (premode == 1)
            norm_pass(F, nullptr, WSP(bf16, WS_H16), WSP(const bf16, WS_XN), GAINS(i, 3), 1, nullptr, nullptr, nullptr, (float*)(F.ctl + CW_ROWINV), true,
                      (const bf16*)(F.ctl + CW_WF) + (size_t)(i >> 1) * 16 * 1024, KA->in[12] + (size_t)(i >> 1) * H, WSP(float, WS_LF_OF(i >> 1)));
        else
            norm_pass(F, nullptr, WSP(bf16, WS_H16), WSP(const bf16, WS_XN), GAINS(i, 3), premode, GAINS(i + 1 < DEPTH ? i + 1 : i, 0), WSP(bf16, WS_AS5), KA->out, (float*)(F.ctl + CW_ROWINV), true);
        if (fin) break;
        GRID_BAR();
    }
#endif
}

extern "C" void kernel_launch(void* const* d_in, const int* in_sizes, int n_in, void* d_out, int out_size, void* d_ws, size_t ws_size, hipStream_t stream) {
    static int grid = 0;
    if (grid == 0) {
        if (n_in != 16 || in_sizes[0] != M * D || out_size != M * D || ws_size < WS_END) { fprintf(stderr, "kernel_launch: unexpected shapes (n_in %d, in0 %d, out %d, ws %zu); nothing launched\n", n_in, n_in > 0 ? in_sizes[0] : -1, out_size, ws_size); grid = -1; return; }
        int dev = 0, cus = 0, per_cu = 0;
        if (hipGetDevice(&dev) != hipSuccess || hipDeviceGetAttribute(&cus, hipDeviceAttributeMultiprocessorCount, dev) != hipSuccess) { grid = -1; return; }
        if (hipFuncSetAttribute((const void*)mk_fwd, hipFuncAttributeMaxDynamicSharedMemorySize, LDS_BYTES) != hipSuccess) { fprintf(stderr, "kernel_launch: hipFuncSetAttribute failed\n"); grid = -1; return; }
        if (hipOccupancyMaxActiveBlocksPerMultiprocessor(&per_cu, (const void*)mk_fwd, NWAVES * 64, LDS_BYTES) != hipSuccess || per_cu < 1) { fprintf(stderr, "kernel_launch: occupancy query says %d\n", per_cu); per_cu = 1; }
        (void)hipGetLastError();
        grid = cus;
    }
    if (grid < 0) return;
    if (hipMemsetAsync((char*)d_ws + WS_CTL, 0, CTL_ZERO_BYTES, stream) != hipSuccess) { fprintf(stderr, "kernel_launch: hipMemsetAsync failed\n"); return; }
    Args a{};
    for (int i = 0; i < 16; ++i) a.in[i] = (const float*)d_in[i];
    a.out = (float*)d_out; a.ws = (unsigned char*)d_ws;
    void* kargv[] = {&a};
    const hipError_t le = hipLaunchCooperativeKernel((const void*)mk_fwd, dim3(grid), dim3(NWAVES * 64), kargv, LDS_BYTES, stream);
    if (le != hipSuccess) fprintf(stderr, "kernel_launch: cooperative launch failed: %s (grid %d)\n", hipGetErrorName(le), grid);
}
```

```cpp
#include <hip/hip_runtime.h>
#include <hip/hip_cooperative_groups.h>
#include <cstdio>
#include <cstdint>
#define NSUB 8
#ifndef PG8_WGM
#define PG8_WGM 8
#endif
namespace pg8 {
#define PG8_LAS __attribute__((address_space(3)))
typedef unsigned short bf16_t;
typedef short bf16x8 __attribute__((ext_vector_type(8)));
typedef float f32x4 __attribute__((ext_vector_type(4)));
typedef unsigned u32x4 __attribute__((ext_vector_type(4)));
constexpr int BM = 256, BK = 64, HALF = 128, HTB = HALF * BK * 2  , STAGE_BYTES = 8 * HTB, NXCD = 8, WGM = 8;

__host__ __device__ __forceinline__ int lds_byte(int r, int c) { const int st = (r >> 4) * 2 + (c >> 5), rr = r & 15, cc = c & 31, ob = rr * 64 + cc * 2; return st * 1024 + (ob ^ (((ob >> 9) & 1) << 5)); }
__host__ __device__ __forceinline__ void stage_rc(int b, int& R, int& C) { const int st = b / 1024, sb = b % 1024, swz = sb ^ (((sb >> 9) & 1) << 5); R = (st >> 1) * 16 + swz / 64; C = (st & 1) * 32 + (swz % 64) / 2; }
__host__ __device__ __forceinline__ int perm32(int rho) { const int n = rho >> 4, i = rho & 15; return 8 * (i >> 2) + 4 * n + (i & 3); }

struct Unit { int pm, pn; };
struct Gemm { const bf16_t* A; const bf16_t* Bt; int M, N, K, lda, ldb, bunit; };

struct StaticOrder {
    int nM, nN, nwg, G, c, wgm;
    __host__ __device__ void init(int M, int N, int G_, int c_, int wgm_ = 4) { nM = M / BM; nN = N / BM; nwg = nM * nN; G = G_; c = c_; wgm = wgm_; }
    __host__ __device__ bool next(int i, Unit& u) const {
        const long L = (long)i * G + c; if (L >= nwg) return false;
        int wgid = (int)L; { const int q = nwg / NXCD, r = nwg % NXCD, xcd = wgid % NXCD, off = wgid / NXCD; wgid = (xcd < r ? xcd * (q + 1) : r * (q + 1) + (xcd - r) * q) + off; }
        const int nig = wgm * nN, gid = wgid / nig, fm = gid * wgm, gsz = (nM - fm) < wgm ? (nM - fm) : wgm;
        u.pm = fm + ((wgid % nig) % gsz); u.pn = (wgid % nig) / gsz; return true;
    }
    __device__ __forceinline__ void a_ready(const Unit&) const {}
    __device__ __forceinline__ void done(const Unit&) const {}
};

__device__ __forceinline__ unsigned cvt_pk_bf16(float lo, float hi) { unsigned r; asm volatile("v_cvt_pk_bf16_f32 %0, %1, %2" : "=v"(r) : "v"(lo), "v"(hi)); return r; }
typedef float f32x2 __attribute__((ext_vector_type(2)));
__device__ __forceinline__ void store8(bf16_t* p, f32x4 v0, f32x4 v1) { u32x4 w; w.x = cvt_pk_bf16(v0[0], v0[1]); w.y = cvt_pk_bf16(v0[2], v0[3]); w.z = cvt_pk_bf16(v1[0], v1[1]); w.w = cvt_pk_bf16(v1[2], v1[3]); *(u32x4*)p = w; }
__device__ __forceinline__ float sigmoidf_(float x) { return __builtin_amdgcn_rcpf(1.0f + __builtin_amdgcn_exp2f(-1.4426950408889634f * x)); }
__device__ __forceinline__ float bf_lo(unsigned w) { return __uint_as_float(w << 16); }
__device__ __forceinline__ float bf_hi(unsigned w) { return __uint_as_float(w & 0xffff0000u); }

struct EpiPlain {
    static constexpr bool PERM = true, AFTER_DRAIN = false;
    bf16_t* O; int ldc;
    __device__ __forceinline__ void operator()(const f32x4 (&acc)[2][2][4][2], const Unit& u, int wr, int wc, int fr, int fq) const {
        const int row0 = u.pm * BM + wr * 64 + fr, col0 = u.pn * BM + wc * 32 + 8 * fq;
#pragma unroll
        for (int ai = 0; ai < 2; ++ai)
#pragma unroll
            for (int m = 0; m < 4; ++m) { bf16_t* rowp = O + (size_t)(row0 + ai * HALF + m * 16) * ldc + col0;
#pragma unroll
                for (int bj = 0; bj < 2; ++bj) store8(rowp + bj * HALF, acc[ai][bj][m][0], acc[ai][bj][m][1]); }
    }
};
struct EpiRelu2 {
    static constexpr bool PERM = true, AFTER_DRAIN = false;
    bf16_t* O; int ldc; const float* rowinv;
    __device__ __forceinline__ void operator()(const f32x4 (&acc)[2][2][4][2], const Unit& u, int wr, int wc, int fr, int fq) const {
        const int row0 = u.pm * BM + wr * 64 + fr, col0 = u.pn * BM + wc * 32 + 8 * fq;
        float invs[2][4];
#pragma unroll
        for (int ai = 0; ai < 2; ++ai)
#pragma unroll
            for (int m = 0; m < 4; ++m) invs[ai][m] = rowinv[row0 + ai * HALF + m * 16];
#pragma unroll
        for (int ai = 0; ai < 2; ++ai)
#pragma unroll
            for (int m = 0; m < 4; ++m) { const int row = row0 + ai * HALF + m * 16; bf16_t* rowp = O + (size_t)row * ldc + col0; const float inv = invs[ai][m];
#pragma unroll
                for (int bj = 0; bj < 2; ++bj) { f32x4 v0 = acc[ai][bj][m][0], v1 = acc[ai][bj][m][1];
#pragma unroll
                    for (int e = 0; e < 4; ++e) { const float a = fmaxf(v0[e], 0.f) * inv, b = fmaxf(v1[e], 0.f) * inv; v0[e] = a * a; v1[e] = b * b; }
                    store8(rowp + bj * HALF, v0, v1); } }
    }
};
struct EpiGLU {
    static constexpr bool PERM = true, AFTER_DRAIN = false;
    bf16_t* O; int ldc;
    __device__ __forceinline__ void operator()(const f32x4 (&acc)[2][2][4][2], const Unit& u, int wr, int wc, int fr, int fq) const {
        const int row0 = u.pm * BM + wr * 64 + fr, col0 = u.pn * HALF + wc * 32 + 8 * fq;
#pragma unroll
        for (int ai = 0; ai < 2; ++ai)
#pragma unroll
            for (int m = 0; m < 4; ++m) { bf16_t* rowp = O + (size_t)(row0 + ai * HALF + m * 16) * ldc + col0;
                f32x4 v0 = acc[ai][0][m][0], v1 = acc[ai][0][m][1]; const f32x4 g0 = acc[ai][1][m][0], g1 = acc[ai][1][m][1];
#pragma unroll
                for (int e = 0; e < 4; ++e) { v0[e] *= sigmoidf_(g0[e]); v1[e] *= sigmoidf_(g1[e]); }
                store8(rowp, v0, v1); }
    }
};
struct EpiProj {
    static constexpr bool PERM = true, AFTER_DRAIN = false;
    bf16_t* QKVG; size_t stride; float qscale; const float* rowinv;
    __device__ __forceinline__ void operator()(const f32x4 (&acc)[2][2][4][2], const Unit& u, int wr, int wc, int fr, int fq) const {
        const int row0 = u.pm * BM + wr * 64 + fr;
        float invs[2][4];
#pragma unroll
        for (int ai = 0; ai < 2; ++ai)
#pragma unroll
            for (int m = 0; m < 4; ++m) invs[ai][m] = rowinv[row0 + ai * HALF + m * 16];
        const int t = u.pn >> 2; bf16_t* base = QKVG + (size_t)t * stride; const int col0 = (u.pn & 3) * BM + wc * 32 + 8 * fq; const float sc = (t == 0) ? qscale : 1.0f;
#pragma unroll
        for (int ai = 0; ai < 2; ++ai)
#pragma unroll
            for (int m = 0; m < 4; ++m) { const int row = row0 + ai * HALF + m * 16; bf16_t* rowp = base + (size_t)row * 1024 + col0; const float sci = sc * invs[ai][m];
#pragma unroll
                for (int bj = 0; bj < 2; ++bj) store8(rowp + bj * HALF, acc[ai][bj][m][0] * sci, acc[ai][bj][m][1] * sci); }
    }
};
struct EpiS5Loc {
    static constexpr bool PERM = true, AFTER_DRAIN = false;
    float* SL;
    __device__ __forceinline__ void operator()(const f32x4 (&acc)[2][2][4][2], const Unit& u, int wr, int wc, int fr, int fq) const {
        const int row0 = u.pm * BM + wr * 64 + fr, col0 = wc * 32 + 8 * fq;
#pragma unroll
        for (int ai = 0; ai < 2; ++ai)
#pragma unroll
            for (int m = 0; m < 4; ++m) { float* rowp = SL + (size_t)(row0 + ai * HALF + m * 16) * 128 + col0; *(f32x4*)rowp = acc[ai][0][m][0]; *(f32x4*)(rowp + 4) = acc[ai][0][m][1]; }
    }
};
struct EpiS5Main {
    static constexpr bool PERM = true, AFTER_DRAIN = false;
    bf16_t* G; const bf16_t* AS5; const float* dskip;
    __device__ __forceinline__ void operator()(const f32x4 (&acc)[2][2][4][2], const Unit& u, int wr, int wc, int fr, int fq) const {
        const int g = u.pn, row0 = u.pm * BM + wr * 64 + fr;
        const int ch0 = g * 16 + 8 * (fq & 1);
        const f32x4 d0 = *(const f32x4*)(dskip + ch0), d1 = *(const f32x4*)(dskip + ch0 + 4);
#pragma unroll
        for (int ai = 0; ai < 2; ++ai) { u32x4 uus[4][2];
#pragma unroll
            for (int m = 0; m < 4; ++m)
#pragma unroll
                for (int bj = 0; bj < 2; ++bj) uus[m][bj] = *(const u32x4*)(AS5 + (size_t)(row0 + ai * HALF + m * 16) * 384 + bj * HALF + wc * 32 + 8 * fq);
#pragma unroll
            for (int m = 0; m < 4; ++m) { const int row = row0 + ai * HALF + m * 16; const int scl = row - g * 2048;
#pragma unroll
                for (int bj = 0; bj < 2; ++bj) { const int c0 = bj * HALF + wc * 32 + 8 * fq; const int t = c0 >> 4;
                    const u32x4 uu = uus[m][bj];
                    f32x4 y0 = acc[ai][bj][m][0], y1 = acc[ai][bj][m][1];
                    y0[0] += d0[0] * bf_lo(uu.x); y0[1] += d0[1] * bf_hi(uu.x); y0[2] += d0[2] * bf_lo(uu.y); y0[3] += d0[3] * bf_hi(uu.y);
                    y1[0] += d1[0] * bf_lo(uu.z); y1[1] += d1[1] * bf_hi(uu.z); y1[2] += d1[2] * bf_lo(uu.w); y1[3] += d1[3] * bf_hi(uu.w);
#pragma unroll
                    for (int e = 0; e < 4; ++e) { const float a = y0[e], b = y1[e];
                        y0[e] = a * sigmoidf_(1.5957691216057308f * (a + 0.044715f * a * a * a)); y1[e] = b * sigmoidf_(1.5957691216057308f * (b + 0.044715f * b * b * b)); }
                    store8(G + ((size_t)scl * 16 + t) * 1024 + ch0, y0, y1); } }
            asm volatile("" ::: "memory"); }
    }
};
struct S5Order {
    int G, c;
    __host__ __device__ void init(int G_, int c_) { G = G_; c = c_; }
    __host__ __device__ bool next(int i, Unit& u) const { const int L = i * G + c; if (L >= 512) return false; u.pm = L; u.pn = L >> 3; return true; }
    __device__ __forceinline__ void a_ready(const Unit&) const {}
    __device__ __forceinline__ void done(const Unit&) const {}
};

struct EpiS5LocCarry {
    static constexpr bool PERM = true, AFTER_DRAIN = true;
    bf16_t* AS5; const float* a_re; const float* a_im; const float* log_dt;
    __device__ __forceinline__ void fused(f32x4 (&acc)[2][2][4][2], const Unit& u, int wr, int wc, int fr, int fq, PG8_LAS unsigned char* lds, int wid, int lane) const {
        PG8_LAS float* T = (PG8_LAS float*)lds;
        const int col0 = wc * 32 + 8 * fq;
#pragma unroll
        for (int ai = 0; ai < 2; ++ai)
#pragma unroll
            for (int m = 0; m < 4; ++m) { PG8_LAS float* rowp = T + (ai * HALF + wr * 64 + m * 16 + fr) * 128 + col0; *(PG8_LAS f32x4*)rowp = acc[ai][0][m][0]; *(PG8_LAS f32x4*)(rowp + 4) = acc[ai][0][m][1]; }
        asm volatile("s_waitcnt lgkmcnt(0)" ::: "memory"); __builtin_amdgcn_s_barrier(); asm volatile("" ::: "memory");
        if (wid == 0) {
            const int g = u.pn, p = lane;
            const float dt = __expf(log_dt[g]); const float are = a_re[g * 64 + p], aim = a_im[g * 64 + p];
            const float mag = __expf(are * dt * 16.f), rev = aim * dt * 16.f * 0.15915494309189535f, rf = rev - floorf(rev);
            const float ar = mag * __builtin_amdgcn_cosf(rf), ai = mag * __builtin_amdgcn_sinf(rf);
            __attribute__((address_space(1))) bf16_t* AS = (__attribute__((address_space(1))) bf16_t*)(AS5 + (size_t)u.pm * BM * 384 + 256);
            float xr = 0.f, xi = 0.f;
#pragma unroll 8
            for (int sc = 0; sc < 256; ++sc) {
                const float lr = T[sc * 128 + p], li = T[sc * 128 + 64 + p];
                AS[(size_t)sc * 384 + p] = (bf16_t)(cvt_pk_bf16(xr, xr) & 0xffffu); AS[(size_t)sc * 384 + 64 + p] = (bf16_t)(cvt_pk_bf16(xi, xi) & 0xffffu);
                const float nr = ar * xr - ai * xi + lr, ni = ar * xi + ai * xr + li; xr = nr; xi = ni;
            }
        }
        asm volatile("s_waitcnt lgkmcnt(0)" ::: "memory"); __builtin_amdgcn_s_barrier(); asm volatile("" ::: "memory");
    }
};
struct S5OneOrder {
    int L;
    __host__ __device__ bool next(int i, Unit& u) const { if (i > 0 || L >= 512) return false; u.pm = L; u.pn = L >> 3; return true; }
    __device__ __forceinline__ void a_ready(const Unit&) const {}
    __device__ __forceinline__ void done(const Unit&) const {}
};

template <class Epi, class Sched, bool ALIGN_EPI = false, bool SP2 = false>
__device__ __forceinline__ void gemm_phase(PG8_LAS unsigned char* lds, const Gemm g, const Sched& S, const Epi& E) {
    int tid_ = threadIdx.x; asm volatile("" : "+v"(tid_)); const int tid = tid_, wid = __builtin_amdgcn_readfirstlane(tid >> 6), lane = tid & 63, wr = wid >> 2, wc = wid & 3, fr = lane & 15, fq = lane >> 4;
    const int K = g.K, nt = K / BK;
    unsigned voffA[2], voffB[2];
#pragma unroll
    for (int i = 0; i < 2; ++i) { int R, C; stage_rc(tid * 16 + i * 8192, R, C); const int Rb = Epi::PERM ? ((R & ~31) + perm32(R & 31)) : R;
        voffA[i] = (unsigned)(R * g.lda + C) * 2u; voffB[i] = (unsigned)(Rb * g.ldb + C) * 2u; }
    const size_t kstep = (size_t)(BK * 2);
    const size_t hstepA = (size_t)HALF * g.lda * 2, hstepB = (size_t)HALF * g.ldb * 2;
    const size_t tstepA = 2 * hstepA, tstepB = (size_t)g.bunit * g.ldb * 2;
    const unsigned ldsw = (unsigned)wid * 1024u;
    const int aoff = lds_byte(wr * 64 + fr, fq * 8), boff = lds_byte(wc * 32 + fr, fq * 8);
#define PG8_SA(b, h) (((b) * 2 + (h)) * HTB)
#define PG8_SB(b, h) ((4 + (b) * 2 + (h)) * HTB)
#define PG8_STAGE(bufoff, gbase, voff) do { _Pragma("unroll") for (int _i = 0; _i < 2; ++_i) \
        __builtin_amdgcn_global_load_lds((const unsigned*)((const char*)(gbase) + (voff)[_i]), (PG8_LAS unsigned*)(lds + (bufoff) + ldsw + _i * 8192), 16, 0, 0); } while (0)
#define PG8_LDA(dst, b, h) do { _Pragma("unroll") for (int m = 0; m < 4; ++m) _Pragma("unroll") for (int k = 0; k < 2; ++k) dst[m][k] = *(const PG8_LAS bf16x8*)(lds + PG8_SA(b, h) + aoff + m * 2048 + k * 1024); } while (0)
#define PG8_LDB(dst, b, h) do { _Pragma("unroll") for (int n = 0; n < 2; ++n) _Pragma("unroll") for (int k = 0; k < 2; ++k) dst[n][k] = *(const PG8_LAS bf16x8*)(lds + PG8_SB(b, h) + boff + n * 2048 + k * 1024); } while (0)
#define PG8_MMA(ai, bj, At, Bt) do { __builtin_amdgcn_s_setprio(1); _Pragma("unroll") for (int m = 0; m < 4; ++m) _Pragma("unroll") for (int n = 0; n < 2; ++n) _Pragma("unroll") for (int k = 0; k < 2; ++k) \
        acc[ai][bj][m][n] = __builtin_amdgcn_mfma_f32_16x16x32_bf16(Bt[n][k], At[m][k], acc[ai][bj][m][n], 0, 0, 0); __builtin_amdgcn_s_setprio(0); } while (0)
#define PG8_WAIT_V(n) asm volatile("s_waitcnt vmcnt(" #n ")" ::: "memory")
#define PG8_WAIT_L(n) asm volatile("s_waitcnt lgkmcnt(" #n ")" ::: "memory")
#define PG8_BAR __builtin_amdgcn_s_barrier()
#define PG8_SCHED __builtin_amdgcn_sched_barrier(0)
    Unit cur, nxt; int ui = 0;
    if (!S.next(0, cur)) return;
    f32x4 acc[2][2][4][2];
#pragma unroll
    for (int a = 0; a < 2; ++a)
#pragma unroll
        for (int b = 0; b < 2; ++b)
#pragma unroll
            for (int m = 0; m < 4; ++m)
#pragma unroll
                for (int n = 0; n < 2; ++n) acc[a][b][m][n] = (f32x4){0.f, 0.f, 0.f, 0.f};
    bf16x8 At[4][2], B0[2][2], B1[2][2];
    const char* cA = (const char*)g.A + (size_t)cur.pm * tstepA; const char* cB = (const char*)g.Bt + (size_t)cur.pn * tstepB;
    S.a_ready(cur);
    if constexpr (SP2) {
        PG8_STAGE(PG8_SB(0, 0), cB, voffB); PG8_STAGE(PG8_SB(0, 1), cB + hstepB, voffB); PG8_STAGE(PG8_SA(0, 0), cA, voffA); PG8_STAGE(PG8_SA(0, 1), cA + hstepA, voffA);
        if (wr == 1) PG8_BAR;
        PG8_WAIT_V(2); PG8_BAR;
        PG8_STAGE(PG8_SB(1, 0), cB + kstep, voffB); PG8_STAGE(PG8_SA(1, 0), cA + kstep, voffA); PG8_STAGE(PG8_SB(1, 1), cB + hstepB + kstep, voffB);
        PG8_WAIT_V(6); PG8_BAR;
    } else {
        PG8_STAGE(PG8_SB(0, 0), cB, voffB); PG8_STAGE(PG8_SA(0, 0), cA, voffA); PG8_STAGE(PG8_SB(0, 1), cB + hstepB, voffB); PG8_STAGE(PG8_SA(0, 1), cA + hstepA, voffA);
        if (wr == 1) PG8_BAR;
        PG8_WAIT_V(4); PG8_BAR;
        PG8_STAGE(PG8_SB(1, 0), cB + kstep, voffB); PG8_STAGE(PG8_SA(1, 0), cA + kstep, voffA); PG8_STAGE(PG8_SB(1, 1), cB + hstepB + kstep, voffB);
        PG8_WAIT_V(6); PG8_BAR;
    }
    for (;;) {
        const bool has_next = S.next(ui + 1, nxt);
        const char* nA = has_next ? (const char*)g.A + (size_t)nxt.pm * tstepA : cA; const char* nB = has_next ? (const char*)g.Bt + (size_t)nxt.pn * tstepB : cB;
_Pragma("nounroll")
        for (int t = 0; t < nt; t += 2) {
            const bool last = (t == nt - 2);
            const char* a1 = cA + (size_t)(t + 1) * kstep;
            const char* a2 = last ? nA : cA + (size_t)(t + 2) * kstep; const char* b2 = last ? nB : cB + (size_t)(t + 2) * kstep;
            const char* a3 = a2 + kstep; const char* b3 = b2 + kstep;
            if (last && has_next) S.a_ready(nxt);
            if constexpr (SP2) {
            PG8_LDB(B0, 0, 0); PG8_LDB(B1, 0, 1); PG8_SCHED; PG8_LDA(At, 0, 0); PG8_STAGE(PG8_SA(1, 1), a1 + hstepA, voffA);
            PG8_WAIT_V(8); PG8_WAIT_L(0); PG8_BAR; PG8_MMA(0, 0, At, B0); PG8_MMA(0, 1, At, B1); PG8_BAR; PG8_SCHED;
            PG8_LDA(At, 0, 1); PG8_STAGE(PG8_SB(0, 0), b2, voffB); PG8_STAGE(PG8_SB(0, 1), b2 + hstepB, voffB); PG8_STAGE(PG8_SA(0, 0), a2, voffA);
            PG8_WAIT_V(8); PG8_WAIT_L(0); PG8_BAR; PG8_MMA(1, 0, At, B0); PG8_MMA(1, 1, At, B1); PG8_BAR; PG8_SCHED;
            PG8_LDB(B0, 1, 0); PG8_LDB(B1, 1, 1); PG8_SCHED; PG8_LDA(At, 1, 0); PG8_STAGE(PG8_SA(0, 1), a2 + hstepA, voffA);
            PG8_WAIT_V(8); PG8_WAIT_L(0); PG8_BAR; PG8_MMA(0, 0, At, B0); PG8_MMA(0, 1, At, B1); PG8_BAR; PG8_SCHED;
            PG8_LDA(At, 1, 1); PG8_STAGE(PG8_SB(1, 0), b3, voffB); PG8_STAGE(PG8_SB(1, 1), b3 + hstepB, voffB); PG8_STAGE(PG8_SA(1, 0), a3, voffA);
            PG8_WAIT_V(8); PG8_WAIT_L(0); PG8_BAR; PG8_MMA(1, 0, At, B0); PG8_MMA(1, 1, At, B1); PG8_BAR; PG8_SCHED;
            } else {
            PG8_LDB(B0, 0, 0); PG8_SCHED; PG8_LDA(At, 0, 0); PG8_STAGE(PG8_SA(1, 1), a1 + hstepA, voffA);
            PG8_WAIT_L(8); PG8_BAR; PG8_WAIT_L(0); PG8_MMA(0, 0, At, B0); PG8_BAR; PG8_SCHED;
            PG8_LDB(B1, 0, 1); PG8_STAGE(PG8_SB(0, 0), b2, voffB);
            PG8_BAR; PG8_WAIT_L(0); PG8_MMA(0, 1, At, B1); PG8_BAR;
            PG8_LDA(At, 0, 1); PG8_STAGE(PG8_SA(0, 0), a2, voffA);
            PG8_BAR; PG8_WAIT_L(0); PG8_MMA(1, 0, At, B0); PG8_BAR; PG8_SCHED;
            PG8_STAGE(PG8_SB(0, 1), b2 + hstepB, voffB);
            PG8_WAIT_V(6); PG8_BAR; PG8_MMA(1, 1, At, B1); PG8_BAR;
            PG8_LDB(B0, 1, 0); PG8_SCHED; PG8_LDA(At, 1, 0); PG8_STAGE(PG8_SA(0, 1), a2 + hstepA, voffA);
            PG8_WAIT_L(8); PG8_BAR; PG8_WAIT_L(0); PG8_MMA(0, 0, At, B0); PG8_BAR; PG8_SCHED;
            PG8_LDB(B1, 1, 1); PG8_STAGE(PG8_SB(1, 0), b3, voffB);
            PG8_BAR; PG8_WAIT_L(0); PG8_MMA(0, 1, At, B1); PG8_BAR;
            PG8_LDA(At, 1, 1); PG8_STAGE(PG8_SA(1, 0), a3, voffA);
            PG8_BAR; PG8_WAIT_L(0); PG8_MMA(1, 0, At, B0); PG8_BAR; PG8_SCHED;
            PG8_STAGE(PG8_SB(1, 1), b3 + hstepB, voffB);
            PG8_WAIT_V(6); PG8_BAR; PG8_MMA(1, 1, At, B1); PG8_BAR;
            }
        }
        if constexpr (ALIGN_EPI) { if (wr == 0) PG8_BAR; }
        if constexpr (!Epi::AFTER_DRAIN) { E(acc, cur, wr, wc, fr, fq); S.done(cur); }
        if (!has_next) break;
#pragma unroll
        for (int a = 0; a < 2; ++a)
#pragma unroll
            for (int b = 0; b < 2; ++b)
#pragma unroll
                for (int m = 0; m < 4; ++m)
#pragma unroll
                    for (int n = 0; n < 2; ++n) acc[a][b][m][n] = (f32x4){0.f, 0.f, 0.f, 0.f};
        cur = nxt; cA = nA; cB = nB; ++ui;
        if constexpr (ALIGN_EPI) { if (wr == 1) PG8_BAR; }
    }
    PG8_WAIT_V(0);
    if constexpr (!ALIGN_EPI) { if (wr == 0) PG8_BAR; }
    PG8_BAR;
    if constexpr (Epi::AFTER_DRAIN) { E.fused(acc, cur, wr, wc, fr, fq, lds, wid, lane); S.done(cur); }
#undef PG8_SA
#undef PG8_SB
#undef PG8_STAGE
#undef PG8_LDA
#undef PG8_LDB
#undef PG8_MMA
#undef PG8_WAIT_V
#undef PG8_WAIT_L
#undef PG8_BAR
#undef PG8_SCHED
}
}

#define PG8_ALIGN true
#include <hip/hip_bf16.h>
#include <cmath>
namespace attn_body {
using bf16=__hip_bfloat16;
using bf16x8=__attribute__((ext_vector_type(8)))short;
using s16x4=__attribute__((ext_vector_type(4)))short;
using f32x16=__attribute__((ext_vector_type(16)))float;
using u32x4=__attribute__((ext_vector_type(4)))unsigned;
using f32x4_t=__attribute__((ext_vector_type(4)))float;
constexpr int BATCH=8,NHEAD=16,SEQ=4096,D=64,DM=NHEAD*D;
constexpr int NW=8,QBLK=32,QB=QBLK*NW,KVBLK=64,NQB=SEQ/QB;
constexpr int ATTN_PITCH=DM, ATTN_UNIT_ROWS=QB;
__device__ __forceinline__ int crow(int r,int hi){return (r&3)+8*(r>>2)+4*hi;}
#define SBAR() __builtin_amdgcn_sched_barrier(0)
__device__ __forceinline__ void cmask(f32x16&p0,f32x16&p1,int jb,int qrel,int hi){
  const float NEG=-INFINITY; int kb=64*jb+4*hi;
  #pragma unroll
  for(int r=0;r<16;++r){int kv=kb+(r&3)+8*(r>>2); if(kv>qrel)p0[r]=NEG; if(kv+32>qrel)p1[r]=NEG;}
}

constexpr int NSLOT=3, SLOTB=8192;
constexpr int LDS_K=0, LDS_V=NSLOT*SLOTB, LDS_WS=2*NSLOT*SLOTB, LDS_OST=LDS_WS+NW*64*4, LDS_CKT=LDS_OST+NW*4096, LDS_BYTES=LDS_CKT+(SEQ+64)*4;
constexpr float SKIP_THR=24.f;
constexpr float C2=0.125f*1.4426950408889634f;
__device__ __forceinline__ void glds16(const void*gsrc,unsigned lds_dst){unsigned keep;
  asm volatile("s_mov_b32 %0, m0\n\ts_mov_b32 m0, %2\n\ts_nop 0\n\tglobal_load_lds_dwordx4 %1, off\n\ts_mov_b32 m0, %0":"=&s"(keep):"v"(gsrc),"s"(lds_dst):"memory");}
__device__ __forceinline__ float max3f(float a,float b,float c){float r;asm("v_max3_f32 %0, %1, %2, %3":"=v"(r):"v"(a),"v"(b),"v"(c));return r;}
__device__ __forceinline__ float max2f(float a,float b){float r;asm("v_max_f32_e32 %0, %1, %2":"=v"(r):"v"(a),"v"(b));return r;}
__device__ __forceinline__ float fadd_s(float a,float b){float r;asm("v_add_f32_e32 %0, %1, %2":"=v"(r):"v"(a),"v"(b));return r;}
__device__ __forceinline__ float fsub_s(float a,float b){float r;asm("v_sub_f32_e32 %0, %1, %2":"=v"(r):"v"(a),"v"(b));return r;}
typedef float f32x2_t __attribute__((ext_vector_type(2))); typedef __bf16 bf16x2_t __attribute__((ext_vector_type(2)));
__device__ __forceinline__ unsigned cvtpk_s(float lo,float hi){f32x2_t v={lo,hi};bf16x2_t b=__builtin_convertvector(v,bf16x2_t);return __builtin_bit_cast(unsigned,b);}
#define WAIT_BAR(N) asm volatile("s_waitcnt vmcnt(" #N ") lgkmcnt(0)\n\ts_barrier":::"memory")

__device__ __forceinline__ void qkt(f32x16&p0,f32x16&p1,const char*Kslot,const bf16x8*qr,int r32,int hi){
  const char*kb=Kslot+hi*1024+r32*16;
  #pragma unroll
  for(int d0=0;d0<4;++d0){
    const bf16x8 b0=*reinterpret_cast<const bf16x8*>(kb+d0*2048);
    const bf16x8 b1=*reinterpret_cast<const bf16x8*>(kb+d0*2048+512);
    {p0=__builtin_amdgcn_mfma_f32_32x32x16_bf16(b0,qr[d0],p0,0,0,0);p1=__builtin_amdgcn_mfma_f32_32x32x16_bf16(b1,qr[d0],p1,0,0,0);}}
}
typedef __attribute__((address_space(3))) const char* lds_cptr;
typedef short v4i16_t __attribute__((ext_vector_type(4)));
__device__ __forceinline__ void kload8(bf16x8*kf,lds_cptr kp){
  kf[0]=*(const __attribute__((address_space(3))) bf16x8*)(kp);      kf[1]=*(const __attribute__((address_space(3))) bf16x8*)(kp+512);
  kf[2]=*(const __attribute__((address_space(3))) bf16x8*)(kp+2048); kf[3]=*(const __attribute__((address_space(3))) bf16x8*)(kp+2560);
  kf[4]=*(const __attribute__((address_space(3))) bf16x8*)(kp+4096); kf[5]=*(const __attribute__((address_space(3))) bf16x8*)(kp+4608);
  kf[6]=*(const __attribute__((address_space(3))) bf16x8*)(kp+6144); kf[7]=*(const __attribute__((address_space(3))) bf16x8*)(kp+6656);
}
__device__ __forceinline__ void kload2(bf16x8*kf,lds_cptr kp,int j){ kf[2*j]=*(const __attribute__((address_space(3))) bf16x8*)(kp+j*2048); kf[2*j+1]=*(const __attribute__((address_space(3))) bf16x8*)(kp+j*2048+512); }
__device__ __forceinline__ s16x4 vtr(lds_cptr p){ return __builtin_bit_cast(s16x4,__builtin_amdgcn_ds_read_tr16_b64_v4i16((__attribute__((address_space(3))) v4i16_t*)p)); }
__device__ __forceinline__ float rowmax(const f32x16&p0,const f32x16&p1){
  float a=max3f(p0[0],p0[1],p1[0]),b=max3f(p0[2],p0[3],p1[1]);a=max3f(a,p1[2],p1[3]);
  #pragma unroll
  for(int r=4;r<16;r+=4){a=max3f(a,p0[r],p0[r+1]);b=max3f(b,p0[r+2],p0[r+3]);a=max3f(a,p1[r],p1[r+1]);b=max3f(b,p1[r+2],p1[r+3]);}
  const float m=max2f(a,b);
  auto rr=__builtin_amdgcn_permlane32_swap(__float_as_uint(m),__float_as_uint(m),false,false);
  return max2f(__uint_as_float(rr[0]),__uint_as_float(rr[1]));
}
__device__ __forceinline__ void pv(f32x16*o,int vb,bf16x8 pa0,bf16x8 pa1,bf16x8 pa2,bf16x8 pa3){
  #pragma unroll
  for(int d0=0;d0<2;++d0){s16x4 lo[4],hi[4];
    #pragma unroll
    for(int ks=0;ks<4;++ks){
      asm volatile("ds_read_b64_tr_b16 %0,%1 offset:%c2":"=&v"(lo[ks]):"v"(vb),"i"(d0*4096+ks*1024):"memory");
      asm volatile("ds_read_b64_tr_b16 %0,%1 offset:%c2":"=&v"(hi[ks]):"v"(vb),"i"(d0*4096+ks*1024+512):"memory");}
    asm volatile("s_waitcnt lgkmcnt(0)":::"memory");SBAR();
    #define PK(k) (bf16x8){lo[k][0],lo[k][1],lo[k][2],lo[k][3],hi[k][0],hi[k][1],hi[k][2],hi[k][3]}
    o[d0]=__builtin_amdgcn_mfma_f32_32x32x16_bf16(pa0,PK(0),o[d0],0,0,0);
    o[d0]=__builtin_amdgcn_mfma_f32_32x32x16_bf16(pa1,PK(1),o[d0],0,0,0);
    o[d0]=__builtin_amdgcn_mfma_f32_32x32x16_bf16(pa2,PK(2),o[d0],0,0,0);
    o[d0]=__builtin_amdgcn_mfma_f32_32x32x16_bf16(pa3,PK(3),o[d0],0,0,0);
    #undef PK
  }
}

#ifndef ATTN_STORE16
#define ATTN_STORE16(p,v) (*(u32x4*)(p)=(v))
#endif
template<int THRL> __device__ __forceinline__ void attn_unit(int b,int h,int qb,const bf16*Q,const bf16*__restrict__ K,const bf16*__restrict__ V,const bf16*__restrict__ GT,const float*__restrict__ CK2,const unsigned*__restrict__ QN2,const unsigned*__restrict__ KN2,const unsigned*__restrict__ DG2,bf16*O,char*shm){
  int tid_=threadIdx.x; asm volatile("":"+v"(tid_)); const int tid=tid_,lane=tid&63,r32=lane&31,hi=lane>>5; const int wid=__builtin_amdgcn_readfirstlane(tid>>6);
  const long rowbase=(long)b*SEQ; const int q0=qb*QB;
  const bf16*Qw=Q+(rowbase+q0+wid*QBLK)*DM+h*D;
  const float*ckg=CK2+((long)(b*NHEAD+h))*SEQ; const int NTF=(q0+QB)/KVBLK; int tskip;
  { const float qn_=sqrtf(__uint_as_float(QN2[(b*NHEAD+h)*NQB+qb])),kn_=sqrtf(__uint_as_float(KN2[b*NHEAD+h])); const float A_=qn_*kn_+__uint_as_float(DG2[(b*NHEAD+h)*NQB+qb])+ckg[q0]+SKIP_THR;
    const float ce_=(lane<NTF)?ckg[64*lane+63]:0.f; const bool pr_=(lane<NTF)&&(A_-ce_<0.f);
    tskip=(int)__popcll(__ballot(pr_)); tskip&=~1; if(tskip>NTF-4)tskip=NTF-4; tskip=__builtin_amdgcn_readfirstlane(tskip); }
  const bf16*Kh=K+(rowbase+(long)tskip*KVBLK)*DM+h*D,*Vh=V+(rowbase+(long)tskip*KVBLK)*DM+h*D;
  const unsigned lds0=(unsigned)(uintptr_t)shm; const lds_cptr shm3=(lds_cptr)shm;
  float*wsf=(float*)(shm+LDS_WS)+wid*64;
  const bf16*ksrc=Kh+(long)lane*DM+wid*8;
  const bf16*vsrc=Vh+(long)(16*(wid&3)+(lane>>2))*DM+(wid>>2)*32+(lane&3)*8;
  const unsigned kdst=lds0+LDS_K+wid*1024, vdst=lds0+LDS_V+wid*1024;
  #define DMA_K(t,slot) glds16(ksrc+(long)(t)*KVBLK*DM,(unsigned)__builtin_amdgcn_readfirstlane(kdst+(slot)))
  #define DMA_V(t,slot) glds16(vsrc+(long)(t)*KVBLK*DM,(unsigned)__builtin_amdgcn_readfirstlane(vdst+(slot)))
  const int vb0=(int)(lds0+LDS_V)+((lane>>4)&1)*32+(lane&3)*8+(4*hi+((lane&15)>>2))*64;
  const char*Kbase=shm+LDS_K; bf16x8 kf[8];
  const lds_cptr kp0=shm3+LDS_K+hi*1024+r32*16; const lds_cptr vp0=shm3+LDS_V+((lane>>4)&1)*32+(lane&3)*8+(4*hi+((lane&15)>>2))*64;
  const int NT=NTF-tskip;
  typedef __attribute__((address_space(3))) float* lds_fptr;
  const lds_fptr ckt=(lds_fptr)(shm3+LDS_CKT);
  { const int n_=q0+QB-64*tskip; const float*cks_=ckg+64*tskip;
    for(int i_=tid*4;i_<n_;i_+=2048){ const f32x4_t v_=*(const __attribute__((address_space(1))) f32x4_t*)(cks_+i_); *(__attribute__((address_space(3))) f32x4_t*)(ckt+i_)=v_; } }
  float cq2=CK2[((long)(b*NHEAD+h))*SEQ+q0+wid*QBLK+r32];
  float base=cq2;
  #define BIAS_INIT(C0,C1,t) do{ const lds_fptr cp_=ckt+64*(t)+4*hi; \
    _Pragma("unroll") for(int j_=0;j_<4;++j_){ const f32x4_t a_=*(const __attribute__((address_space(3))) f32x4_t*)(cp_+8*j_); const f32x4_t b_=*(const __attribute__((address_space(3))) f32x4_t*)(cp_+32+8*j_); \
      C0[4*j_]=base-a_[0];C0[4*j_+1]=base-a_[1];C0[4*j_+2]=base-a_[2];C0[4*j_+3]=base-a_[3]; C1[4*j_]=base-b_[0];C1[4*j_+1]=base-b_[1];C1[4*j_+2]=base-b_[2];C1[4*j_+3]=base-b_[3]; } }while(0)
  DMA_K(0,0);DMA_V(0,0);DMA_K(1,SLOTB);
  bf16x8 qr[4];
  #pragma unroll
  for(int d0=0;d0<4;++d0)qr[d0]=*reinterpret_cast<const bf16x8*>(&Qw[(long)r32*DM+d0*16+hi*8]);
  float mhat=0.f,l_reg=0.f;f32x16 o[2];o[0]=f32x16{};o[1]=f32x16{};
  const int qrel=wid*QBLK+r32;
  #define CMASK(P0,P1,t) do{int jb_=(t)-(NT-4); if(jb_>=0)cmask(P0,P1,jb_,qrel,hi);}while(0)
  bool resc=false;
  #define START(P0,P1) do{ const float rm=rowmax(P0,P1); resc=false; \
    { const float dl=rm; mhat=fadd_s(mhat,dl); \
      _Pragma("unroll") for(int r=0;r<16;++r){P0[r]=fsub_s(P0[r],dl);P1[r]=fsub_s(P1[r],dl);} \
      base=cq2-mhat; } \
    _Pragma("unroll") for(int r=0;r<16;++r)P0[r]=__builtin_amdgcn_exp2f(P0[r]); }while(0)
  #define RESC() do{ if(resc){ asm volatile("s_waitcnt lgkmcnt(0)":::"memory"); \
      _Pragma("unroll") for(int d_=0;d_<2;++d_) _Pragma("unroll") for(int r=0;r<16;++r)o[d_][r]*=wsf[crow(r,hi)]; } }while(0)
  f32x16 pA0,pA1,pB0,pB1;
  int sl_prev=0,sl_cur=0,sl_next=SLOTB;
  #define ROT() do{sl_prev=sl_cur;sl_cur=sl_next;sl_next=(sl_next==(NSLOT-1)*SLOTB)?0:sl_next+SLOTB;}while(0)
  DMA_K(2,2*SLOTB);
  WAIT_BAR(3);
  BIAS_INIT(pA0,pA1,0); qkt(pA0,pA1,Kbase,qr,r32,hi);asm volatile("s_nop 15\n\ts_nop 7":"+v"(pA0),"+v"(pA1));CMASK(pA0,pA1,0);
  START(pA0,pA1);
  _Pragma("unroll") for(int r=0;r<16;++r)pA1[r]=__builtin_amdgcn_exp2f(pA1[r]);
  WAIT_BAR(0);
  DMA_K(3,0);DMA_V(1,SLOTB);
  ROT();
  kload8(kf,kp0+sl_cur);
  WAIT_BAR(2);
  s16x4 vlo[8],vhi[8]; u32x4 pw0,pw1,pw2,pw3;
  #define PKW(P,B) cvtpk_s(P[B],P[B+1])
  #define PAF(k) __builtin_bit_cast(bf16x8,pw##k)
  #define VFR(i) (bf16x8){vlo[i][0],vlo[i][1],vlo[i][2],vlo[i][3],vhi[i][0],vhi[i][1],vhi[i][2],vhi[i][3]}
  #define PIN(x) asm volatile("":"+v"(x))
  #define MX3(a,b,c) __builtin_fmaxf(__builtin_fmaxf((a),(b)),(c))
  #define GAPA(MF,A0,A1,A2,A3,W0,W1,PW) do{ MF; sacc+=A0; sacc+=A1; sacc+=A2; sacc+=A3; PIN(sacc); W0; W1; PIN(PW); SBAR(); }while(0)
  #define EX(v) __builtin_amdgcn_exp2f(v)
  #define GAPB(MF,X,B) do{ MF; X[B]=EX(X[B]); X[B+1]=EX(X[B+1]); X[B+2]=EX(X[B+2]); X[B+3]=EX(X[B+3]); PIN(X); SBAR(); }while(0)
  #define VRD(i) do{ vlo[i]=vtr(vp_+(((i)>>2)*4096+((i)&3)*1024)); vhi[i]=vtr(vp_+(((i)>>2)*4096+((i)&3)*1024+512)); }while(0)
  #define KRD(G,j) do{ if(G){ kload2(kf,kp0+sl_next,j); SBAR(); } }while(0)
  #define STEP(C0,C1,P0,P1,t,GK,GV,GL) do{ SBAR(); BIAS_INIT(C0,C1,t); SBAR(); \
    const lds_cptr vp_=vp0+sl_prev; \
    VRD(0); SBAR(); float sacc=(P0[0]+P0[1]); \
    GAPA(C0=__builtin_amdgcn_mfma_f32_32x32x16_bf16(kf[0],qr[0],C0,0,0,0), P0[2],P0[3],P0[4],P0[5],     pw0[0]=PKW(P0,0), pw0[1]=PKW(P0,2), pw0); \
    VRD(4); SBAR(); GAPA(C1=__builtin_amdgcn_mfma_f32_32x32x16_bf16(kf[1],qr[0],C1,0,0,0), P0[6],P0[7],P0[8],P0[9],     pw0[2]=PKW(P0,4), pw0[3]=PKW(P0,6), pw0); \
    VRD(1); SBAR(); GAPA(C0=__builtin_amdgcn_mfma_f32_32x32x16_bf16(kf[2],qr[1],C0,0,0,0),   P0[10],P0[11],P0[12],P0[13], pw1[0]=PKW(P0,8), pw1[1]=PKW(P0,10), pw1); \
    VRD(5); SBAR(); GAPA(C1=__builtin_amdgcn_mfma_f32_32x32x16_bf16(kf[3],qr[1],C1,0,0,0),   P0[14],P0[15],P1[0],P1[1],   pw1[2]=PKW(P0,12),pw1[3]=PKW(P0,14), pw1); \
    VRD(2); SBAR(); GAPA(C0=__builtin_amdgcn_mfma_f32_32x32x16_bf16(kf[4],qr[2],C0,0,0,0),   P1[2],P1[3],P1[4],P1[5],     pw2[0]=PKW(P1,0), pw2[1]=PKW(P1,2), pw2); \
    VRD(6); SBAR(); GAPA(C1=__builtin_amdgcn_mfma_f32_32x32x16_bf16(kf[5],qr[2],C1,0,0,0),   P1[6],P1[7],P1[8],P1[9],     pw2[2]=PKW(P1,4), pw2[3]=PKW(P1,6), pw2); \
    VRD(3); SBAR(); GAPA(C0=__builtin_amdgcn_mfma_f32_32x32x16_bf16(kf[6],qr[3],C0,0,0,0),   P1[10],P1[11],P1[12],P1[13], pw3[0]=PKW(P1,8), pw3[1]=PKW(P1,10), pw3); \
    VRD(7); SBAR(); GAPA(C1=__builtin_amdgcn_mfma_f32_32x32x16_bf16(kf[7],qr[3],C1,0,0,0),   P1[14],P1[15],0.f,0.f,       pw3[2]=PKW(P1,12),pw3[3]=PKW(P1,14), pw3); \
    l_reg+=sacc; \
    if(GK){DMA_K((t)+3,sl_cur);} if(GV){DMA_V((t)+1,sl_next);} \
    CMASK(C0,C1,t); \
    { float a=MX3(C0[0],C0[1],C1[0]),b=MX3(C0[2],C0[3],C1[1]); a=MX3(a,C1[2],C1[3]); \
      _Pragma("unroll") for(int r=4;r<16;r+=4){a=MX3(a,C0[r],C0[r+1]);b=MX3(b,C0[r+2],C0[r+3]);a=MX3(a,C1[r],C1[r+1]);b=MX3(b,C1[r+2],C1[r+3]);} \
      float rm=__builtin_fmaxf(a,b); { auto rr=__builtin_amdgcn_permlane32_swap(__float_as_uint(rm),__float_as_uint(rm),false,false); rm=__builtin_fmaxf(__uint_as_float(rr[0]),__uint_as_float(rr[1])); } \
      resc=false; \
      if(__builtin_expect(__any(rm>(float)THRL),0)){ const float dl=__builtin_fmaxf(rm,0.f); mhat+=dl; \
        _Pragma("unroll") for(int r=0;r<16;++r){C0[r]-=dl;C1[r]-=dl;} \
        base=cq2-mhat; \
        const float f=__builtin_amdgcn_exp2f(-dl); l_reg*=f; if(hi==0)wsf[r32]=f; resc=true; } } \
    SBAR(); \
    GAPB(o[0]=__builtin_amdgcn_mfma_f32_32x32x16_bf16(PAF(0),VFR(0),o[0],0,0,0), C0,0); \
    GAPB(o[1]=__builtin_amdgcn_mfma_f32_32x32x16_bf16(PAF(0),VFR(4),o[1],0,0,0), C0,4); \
    KRD(GL,0); GAPB(o[0]=__builtin_amdgcn_mfma_f32_32x32x16_bf16(PAF(1),VFR(1),o[0],0,0,0), C0,8); \
    KRD(GL,1); GAPB(o[1]=__builtin_amdgcn_mfma_f32_32x32x16_bf16(PAF(1),VFR(5),o[1],0,0,0), C0,12); \
    KRD(GL,2); GAPB(o[0]=__builtin_amdgcn_mfma_f32_32x32x16_bf16(PAF(2),VFR(2),o[0],0,0,0), C1,0); \
    KRD(GL,3); GAPB(o[1]=__builtin_amdgcn_mfma_f32_32x32x16_bf16(PAF(2),VFR(6),o[1],0,0,0), C1,4); \
    GAPB(o[0]=__builtin_amdgcn_mfma_f32_32x32x16_bf16(PAF(3),VFR(3),o[0],0,0,0), C1,8); \
    GAPB(o[1]=__builtin_amdgcn_mfma_f32_32x32x16_bf16(PAF(3),VFR(7),o[1],0,0,0), C1,12); \
    }while(0)
  int t=1;
  #undef CMASK
  #define CMASK(P0,P1,t) do{}while(0)
  for(;t+5<NT;t+=2){
    STEP(pB0,pB1,pA0,pA1,t,true,true,true);     WAIT_BAR(2); RESC(); ROT();
    STEP(pA0,pA1,pB0,pB1,t+1,true,true,true);   WAIT_BAR(2); RESC(); ROT();
  }
  #undef CMASK
  #define CMASK(P0,P1,t) do{int jb_=(t)-(NT-4); if(jb_>=0)cmask(P0,P1,jb_,qrel,hi);}while(0)
  #define ENDW(tt) do{ if((tt)+3<NT){WAIT_BAR(2);} else if((tt)+2<NT){WAIT_BAR(1);} else {WAIT_BAR(0);} }while(0)
  for(;t+1<NT;t+=2){
    STEP(pB0,pB1,pA0,pA1,t,(t+3<NT),(t+1<NT),(t+1<NT));       ENDW(t);   RESC(); ROT();
    STEP(pA0,pA1,pB0,pB1,t+1,(t+4<NT),(t+2<NT),(t+2<NT));     ENDW(t+1); RESC(); ROT();
  }
  STEP(pB0,pB1,pA0,pA1,NT-1,false,false,false); RESC();
  { float sacc=pB0[0]+pB0[1]; _Pragma("unroll") for(int r=2;r<16;++r)sacc+=pB0[r]; _Pragma("unroll") for(int r=0;r<16;++r)sacc+=pB1[r]; l_reg+=sacc;
    pw0=(u32x4){PKW(pB0,0),PKW(pB0,2),PKW(pB0,4),PKW(pB0,6)};pw1=(u32x4){PKW(pB0,8),PKW(pB0,10),PKW(pB0,12),PKW(pB0,14)};pw2=(u32x4){PKW(pB1,0),PKW(pB1,2),PKW(pB1,4),PKW(pB1,6)};pw3=(u32x4){PKW(pB1,8),PKW(pB1,10),PKW(pB1,12),PKW(pB1,14)};
    SBAR(); pv(o,vb0+sl_cur,PAF(0),PAF(1),PAF(2),PAF(3)); }
  #undef PKW
  #undef PAF
  #undef VFR
  #undef PIN
  #undef MX3
  #undef GAPA
  #undef GAPB
  #undef EX
  #undef VRD
  #undef KRD
  #undef STEP
  #undef ENDW
  {auto rr=__builtin_amdgcn_permlane32_swap(__float_as_uint(l_reg),__float_as_uint(l_reg),false,false);l_reg=__uint_as_float(rr[0])+__uint_as_float(rr[1]);}
  if(hi==0)wsf[32+r32]=l_reg;asm volatile("s_waitcnt lgkmcnt(0)":::"memory");
  float rli[16];
  #pragma unroll
  for(int r=0;r<16;++r)rli[r]=__builtin_amdgcn_rcpf(wsf[32+crow(r,hi)]);
  bf16*Ow=O+(rowbase+q0+wid*QBLK)*DM+h*D; const bf16*Gw=GT+(rowbase+q0+wid*QBLK)*DM+h*D;
  u32x4 ggs[4];
  _Pragma("unroll") for(int i=0;i<4;++i){const int row=i*8+(lane>>3),ch=lane&7; ggs[i]=*(const u32x4*)(Gw+(long)row*DM+ch*8);}
  { bf16*stg=(bf16*)(shm+LDS_OST)+wid*2048;
    #pragma unroll
    for(int r=0;r<16;++r){const int orow=crow(r,hi);
      #pragma unroll
      for(int d0=0;d0<2;++d0)stg[orow*64+d0*32+r32]=__float2bfloat16(o[d0][r]*rli[r]);}
    asm volatile("s_waitcnt lgkmcnt(0)":::"memory");
    #pragma unroll
    for(int i=0;i<4;++i){const int row=i*8+(lane>>3),ch=lane&7; u32x4 v=*(const u32x4*)(stg+row*64+ch*8); const u32x4 gg=ggs[i];
      #pragma unroll
      for(int e=0;e<4;++e){ const float olo=__uint_as_float(v[e]<<16),ohi=__uint_as_float(v[e]&0xffff0000u),glo=__uint_as_float(gg[e]<<16),ghi=__uint_as_float(gg[e]&0xffff0000u);
        const float slo=__builtin_amdgcn_rcpf(1.0f+__builtin_amdgcn_exp2f(-1.4426950408889634f*glo)),shi=__builtin_amdgcn_rcpf(1.0f+__builtin_amdgcn_exp2f(-1.4426950408889634f*ghi));
        v[e]=cvtpk_s(olo*slo,ohi*shi); }
      ATTN_STORE16(Ow+(long)row*DM+ch*8,v);} }
  asm volatile("s_waitcnt lgkmcnt(0)\n\ts_barrier":::"memory");
  #undef BIAS_INIT
  #undef DMA_K
  #undef DMA_V
  #undef CMASK
  #undef START
  #undef RESC
  #undef ROT
}
constexpr int ATTN_LDS_BYTES=LDS_BYTES;
struct AttnTensors { const bf16* Q; const bf16* K; const bf16* V; const bf16* G; const float* CK2; const unsigned* QN2; const unsigned* KN2; const unsigned* DG2; bf16* O; };
struct AttnUnit { int bh; int qb; };
struct StaticOrder {
  int vcu;
  __device__ __forceinline__ explicit StaticOrder(int grid,int block):vcu((block%8)*(grid/8)+block/8){}
  __device__ __forceinline__ bool next(int i,AttnUnit&u)const{ if(i>=8)return false; const int s=2*(i>>1)+(vcu&1); u.bh=vcu>>1; u.qb=(i&1)?s:15-s; return true; }
  __device__ __forceinline__ void a_ready(const AttnUnit&)const{}
  __device__ __forceinline__ void done(const AttnUnit&)const{}
};
struct QueueOrder {
  unsigned* ctr; volatile __attribute__((address_space(3))) unsigned* slot;
  __device__ __forceinline__ bool next(int,AttnUnit&u)const{
    if(threadIdx.x==0){ const unsigned v_=__hip_atomic_fetch_add(ctr,1u,__ATOMIC_RELAXED,__HIP_MEMORY_SCOPE_AGENT); *slot=v_; }
    asm volatile("s_waitcnt vmcnt(0) lgkmcnt(0)\n\ts_barrier":::"memory");
    const unsigned v=(unsigned)__builtin_amdgcn_readfirstlane(*slot);
    if(v>=(unsigned)(BATCH*NHEAD*NQB))return false; u.qb=NQB-1-(int)(v>>7); u.bh=(int)(v&127u); return true; }
  __device__ __forceinline__ void a_ready(const AttnUnit&)const{}
  __device__ __forceinline__ void done(const AttnUnit&)const{}
};
template<class Sched,int THRL=8> __device__ __forceinline__ void attn_phase(char*lds,const AttnTensors&T,const Sched&S){
  AttnUnit u;
  for(int i=0;S.next(i,u);++i){ S.a_ready(u); attn_unit<THRL>(u.bh/NHEAD,u.bh%NHEAD,u.qb,T.Q,T.K,T.V,T.G,T.CK2,T.QN2,T.KN2,T.DG2,T.O,lds); S.done(u); }
}
#undef SBAR
#undef WAIT_BAR
}
constexpr int NWAVES = 8;
#ifndef WGM_MLP1
#define WGM_MLP1 4
#endif
#ifndef WGM_MLP2
#define WGM_MLP2 4
#endif
#ifndef WGM_PROJ
#define WGM_PROJ 4
#endif
#ifndef WGM_GLU
#define WGM_GLU 4
#endif
#ifndef WGM_WO
#define WGM_WO 4
#endif
#ifndef NSUB
#define NSUB 8
#endif
constexpr int NB = 8, T = 4096, D = 1024, H = 16, HD = 64, FF = 4096, DEPTH = 4;
constexpr int M = NB * T;
constexpr int NPROJ = 4096;
constexpr int NPROJ_REAL = 4 * D + H;
constexpr float RMS_EPS = 1e-6f;
constexpr int S5G = 64, S5P = 64, S5H = 16, TC = 16, NSC = M / TC;
constexpr int S5KA = 384;

constexpr size_t MiB = 1u << 20;
constexpr size_t WS_CTL = 0, CTL_ZERO_BYTES = 1 * MiB;
constexpr size_t WS_WGLU = 1 * MiB;
constexpr size_t WS_WIN = 9 * MiB;
constexpr size_t WS_WOUT = 26 * MiB;
constexpr size_t WS_W1 = 30 * MiB;
constexpr size_t WS_W2 = 62 * MiB;
constexpr size_t WS_S5BM = 94 * MiB;
constexpr size_t WS_S5BS = 118 * MiB;
constexpr size_t WS_H16 = 126 * MiB;
constexpr size_t WS_XN = 190 * MiB;
#define WS_LF_OF(jf) (WS_S5BS + (size_t)(jf) * 4 * MiB)
constexpr size_t WS_CK2 = WS_XN + 2 * MiB;
constexpr size_t WS_BIG = 254 * MiB;
constexpr size_t WS_Q = WS_BIG, WS_K = WS_BIG + 64 * MiB, WS_V = WS_BIG + 128 * MiB, WS_GATE = WS_BIG + 192 * MiB;
constexpr size_t WS_AS5 = WS_BIG, WS_SL = WS_BIG + 96 * MiB, WS_G = WS_BIG + 160 * MiB;
constexpr size_t WS_END = 510 * MiB;
static_assert((size_t)64 * 2048 * 384 * 2 == 96 * MiB && (size_t)M * FF * 2 == 256 * MiB, "map");
constexpr int CW_WF = 163840;
constexpr int CW_ROWINV = 131072;
constexpr int CW_BAR = 4096;
constexpr int CW_QN2 = 32768, CW_KN2 = 40960, CW_QCTR = 45056, CW_DG2 = 49152;

constexpr int RING_OFF = 0, RING_BYTES = 131072;
constexpr int LDSCTL_OFF = RING_BYTES, MISC_OFF = LDSCTL_OFF + 320;
constexpr int LDS_BYTES = 147456;
static_assert(MISC_OFF + 128 <= LDS_BYTES, "LDS map");

struct Args { const float* in[16]; float* out; unsigned char* ws; };
#define GAS __attribute__((address_space(1)))
#define LAS __attribute__((address_space(3)))
typedef unsigned short bf16;
typedef unsigned v4u __attribute__((ext_vector_type(4)));
typedef float f32x4 __attribute__((ext_vector_type(4)));
typedef short bf16x8 __attribute__((ext_vector_type(8)));
typedef GAS unsigned gu32;
typedef GAS unsigned long long gu64;
#define RLX_AGENT __ATOMIC_RELAXED, __HIP_MEMORY_SCOPE_AGENT
#define LDS_WAIT() asm volatile("s_waitcnt lgkmcnt(0)" ::: "memory")
#define VM_WAIT() asm volatile("s_waitcnt vmcnt(0)" ::: "memory")
__device__ __forceinline__ unsigned long long rt() { return __builtin_amdgcn_s_memrealtime(); }
__device__ __forceinline__ unsigned f2bf(float f) { unsigned u = __builtin_bit_cast(unsigned, f); return (u + 0x7fffu + ((u >> 16) & 1u)) >> 16; }
__device__ __forceinline__ unsigned pk2(float lo, float hi) { return f2bf(lo) | (f2bf(hi) << 16); }

#define XB_TMO      128
#define XB_XCNT(j)  (256  + 64 * (j))
#define XB_XSUB(j)  (1280 + 64 * (j))
#define XB_XGEN(j)  (2304 + 64 * (j))
#define XB_TOP      3328
#define XB_TOPGEN   3392
#define XCD_BAR_WORDS 3456
#define XB_SPIN_CAP (1u << 18)

__device__ __forceinline__ unsigned xb_ld(unsigned* p)              { return __hip_atomic_load(p, __ATOMIC_RELAXED, __HIP_MEMORY_SCOPE_AGENT); }
__device__ __forceinline__ unsigned xb_add(unsigned* p, unsigned v) { return __hip_atomic_fetch_add(p, v, __ATOMIC_RELAXED, __HIP_MEMORY_SCOPE_AGENT); }
__device__ __forceinline__ unsigned xb_xcc_id() { return (unsigned)__builtin_amdgcn_s_getreg((3 << 11) | 20) & 0xFu; }
#define XB_SPIN(cond, bar) do { unsigned _sp = 0; while (cond) { __builtin_amdgcn_s_sleep(1); \
    if ((++_sp & 255u) == 0u) { if (xb_ld(&(bar)[XB_TMO])) break; if (_sp > XB_SPIN_CAP) { atomicAdd(&(bar)[XB_TMO], 1u); break; } } } } while (0)

struct XcdBarrier {
    unsigned* bar; unsigned x;
    volatile LAS unsigned* st;
};

__device__ __forceinline__ XcdBarrier xcd_barrier_post(unsigned* bar, volatile LAS unsigned* st) {
    XcdBarrier b; b.bar = bar; b.x = xb_xcc_id(); b.st = st;
    if (threadIdx.x == 0) (void)xb_add(&bar[XB_XCNT(b.x)], 1u);
    return b;
}
__device__ __forceinline__ void xcd_barrier_complete(unsigned* bar, unsigned x, unsigned& nloc, unsigned& nx) {
    const unsigned G = gridDim.x * gridDim.y * gridDim.z;
    unsigned sum, cnt, mine, sp = 0u;
    for (;;) {
        sum = 0u; cnt = 0u; mine = 0u;
#pragma unroll
        for (unsigned j = 0; j < 16; ++j) { const unsigned c = xb_ld(&bar[XB_XCNT(j)]); sum += c; cnt += (c > 0u) ? 1u : 0u; mine = (j == x) ? c : mine; }
        if (sum == G) break;
        __builtin_amdgcn_s_sleep(1);
        if ((++sp & 255u) == 0u) { if (xb_ld(&bar[XB_TMO])) break; if (sp > XB_SPIN_CAP) { atomicAdd(&bar[XB_TMO], 1u); break; } }
    }
    nloc = mine > 0u ? mine : 1u; nx = cnt > 0u ? cnt : 1u;
}

__device__ __forceinline__ void xcd_barrier(const XcdBarrier& b) {
    asm volatile("s_waitcnt vmcnt(0)" ::: "memory");
    __syncthreads();
    if (threadIdx.x == 0) {
        unsigned* bar = b.bar;
        __builtin_amdgcn_s_waitcnt(0);
        unsigned nloc = b.st[0], nx = b.st[1];
        if (nloc == 0u) { xcd_barrier_complete(bar, b.x, nloc, nx); b.st[0] = nloc; b.st[1] = nx; }
        const unsigned old = xb_add(&bar[XB_XSUB(b.x)], 1u);
        const unsigned gen = old / nloc;
        if (old + 1u == (gen + 1u) * nloc) {
            __builtin_amdgcn_fence(__ATOMIC_RELEASE, "agent");
            asm volatile("s_waitcnt vmcnt(0)" ::: "memory");
            const unsigned og = xb_add(&bar[XB_TOP], 1u);
            const unsigned tg = og / nx;
            if (og + 1u == (tg + 1u) * nx) xb_add(&bar[XB_TOPGEN], 1u);
            else XB_SPIN(xb_ld(&bar[XB_TOPGEN]) == tg, bar);
            __builtin_amdgcn_fence(__ATOMIC_ACQUIRE, "agent");
            xb_add(&bar[XB_XGEN(b.x)], 1u);
            asm volatile("s_waitcnt vmcnt(0)" ::: "memory");
        } else {
            XB_SPIN(xb_ld(&bar[XB_XGEN(b.x)]) == gen, bar);
            __builtin_amdgcn_fence(__ATOMIC_ACQUIRE, "agent");
            asm volatile("s_waitcnt vmcnt(0)" ::: "memory");
        }
    }
    __syncthreads();
}
typedef const __attribute__((address_space(4))) Args* KArgsP;
__device__ __forceinline__ KArgsP kargs() { KArgsP p = (KArgsP)__builtin_amdgcn_kernarg_segment_ptr(); asm volatile("" : "+s"(p)); return p; }
#define KA (kargs())

struct Frame {
    LAS unsigned char* lds;
    volatile LAS unsigned* MISC;
    gu32* ctl;
    int tid, lane, wave;
    int vcu, G;
};
__device__ __forceinline__ float wave_sum(float v) {
#pragma unroll
    for (int o = 1; o < 64; o <<= 1) v += __shfl_xor(v, o);
    return v;
}
__device__ __forceinline__ void p0_transpose_item(const float* W, int K, int N, bf16* WT, int k0, int n0, int dst_row0, const float* gain, LAS float* scr, int lane) {
    const int n = n0 + (lane & 31); const GAS float* Wg = (const GAS float*)W + (size_t)k0 * N + (n < N ? n : 0); const GAS float* gg = (const GAS float*)gain + k0;
#pragma unroll 1
    for (int h = 0; h < 2; ++h) {
        float wv[16]; const GAS float* Wh = Wg + (size_t)(32 * h + (lane >> 5)) * N;
#pragma unroll
        for (int i = 0; i < 16; ++i) wv[i] = Wh[(size_t)(2 * i) * N];
#pragma unroll
        for (int i = 0; i < 16; ++i) { const int kk = 32 * h + 2 * i + (lane >> 5); float w = (n < N) ? wv[i] : 0.f; if (gain) w *= gg[kk]; scr[kk * 33 + (lane & 31)] = w; }
    }
    LDS_WAIT(); asm volatile("" ::: "memory");
    const int c = lane & 7;
#pragma unroll
    for (int j = 0; j < 4; ++j) { const int nn = (lane >> 3) + 8 * j; const LAS float* s = scr + (8 * c) * 33 + nn;
        v4u o; o.x = pk2(s[0 * 33], s[1 * 33]); o.y = pk2(s[2 * 33], s[3 * 33]); o.z = pk2(s[4 * 33], s[5 * 33]); o.w = pk2(s[6 * 33], s[7 * 33]);
        *(GAS v4u*)(WT + (size_t)(dst_row0 + nn) * K + k0 + 8 * c) = o; }
    LDS_WAIT(); asm volatile("" ::: "memory");
}
__device__ __forceinline__ float cos_rev(float r) { return __builtin_amdgcn_cosf(r - floorf(r)); }
__device__ __forceinline__ float sin_rev(float r) { return __builtin_amdgcn_sinf(r - floorf(r)); }
constexpr float INV_2PI = 0.15915494309189535f;

__device__ __forceinline__ void s5_prep(Frame& F, int j, int g, int half) { const KArgsP a = KA;
    LAS float* L = (LAS float*)(F.lds + RING_OFF);
    LAS float* APr = L; LAS float* APi = L + 17 * 64; LAS float* BBr = L + 2 * 17 * 64; LAS float* BBi = BBr + 1024; LAS float* CCr = BBi + 1024; LAS float* CCi = CCr + 1024; LAS float* KK = CCi + 1024;
    const int tid = F.tid; const int jg = j * 64 + g;
    const float dt = __expf(a->in[4][jg]);
    for (int idx = tid; idx < 17 * 64; idx += 512) { const int jj = idx >> 6, p = idx & 63; const float are = a->in[2][jg * 64 + p], aim = a->in[3][jg * 64 + p];
        const float mag = __expf(are * dt * (float)jj), rev = aim * dt * (float)jj * INV_2PI; APr[idx] = mag * cos_rev(rev); APi[idx] = mag * sin_rev(rev); }
    for (int idx = tid; idx < 1024; idx += 512) { const int p = idx >> 4; const float are = a->in[2][jg * 64 + p], aim = a->in[3][jg * 64 + p];
        const float x = are * dt, rev = aim * dt * INV_2PI;
        const float em1 = x * (1.f + x * (0.5f + x * (0.16666667f + x * (0.041666668f + x * 0.008333334f))));
        const float c = cos_rev(rev), s = sin_rev(rev), sh = sin_rev(0.5f * rev);
        const float nr = em1 * c - 2.f * sh * sh, ni = (em1 + 1.f) * s;
        const float den = 1.f / (are * are + aim * aim), qr = (nr * are + ni * aim) * den, qi = (ni * are - nr * aim) * den;
        const float br = a->in[5][(size_t)jg * 1024 + idx], bi = a->in[6][(size_t)jg * 1024 + idx];
        BBr[idx] = qr * br - qi * bi; BBi[idx] = qr * bi + qi * br;
        CCr[idx] = a->in[7][(size_t)jg * 1024 + idx]; CCi[idx] = a->in[8][(size_t)jg * 1024 + idx]; }
    LDS_WAIT(); __syncthreads();
    { const int h = (tid >> 4) & 15, hp = tid & 15, j0 = (tid >> 8) * 8; float accj[8];
#pragma unroll
        for (int q = 0; q < 8; ++q) accj[q] = 0.f;
        for (int p = 0; p < 64; ++p) { const float cr = CCr[h * 64 + p], ci = CCi[h * 64 + p], br = BBr[p * 16 + hp], bi = BBi[p * 16 + hp];
            const float er = cr * br - ci * bi, ei = cr * bi + ci * br;
#pragma unroll
            for (int q = 0; q < 8; ++q) accj[q] += er * APr[(j0 + q) * 64 + p] - ei * APi[(j0 + q) * 64 + p]; }
#pragma unroll
        for (int q = 0; q < 8; ++q) KK[(j0 + q) * 256 + h * 16 + hp] = accj[q]; }
    LDS_WAIT(); __syncthreads();
    bf16* Bm = (bf16*)(a->ws + WS_S5BM) + (size_t)jg * 256 * 384;
    for (int pc = tid + half * 128 * 48; pc < (half + 1) * 128 * 48; pc += 512) { const int row = pc / 48, cp = pc % 48, t = row >> 4, h = row & 15, c0 = cp * 8; float v[8];
        if (c0 < 256) { const int s = c0 >> 4, hp0 = c0 & 15;
#pragma unroll
            for (int e = 0; e < 8; ++e) v[e] = (s <= t) ? KK[(t - s) * 256 + h * 16 + hp0 + e] : 0.f;
        } else { const int pp = c0 - 256;
#pragma unroll
            for (int e = 0; e < 8; ++e) { const int p = (pp + e) & 63; const float cr = CCr[h * 64 + p], ci = CCi[h * 64 + p], ar = APr[(t + 1) * 64 + p], ai = APi[(t + 1) * 64 + p];
                v[e] = (pp < 64) ? (cr * ar - ci * ai) : -(cr * ai + ci * ar); } }
        v4u o; o.x = pk2(v[0], v[1]); o.y = pk2(v[2], v[3]); o.z = pk2(v[4], v[5]); o.w = pk2(v[6], v[7]);
        *(GAS v4u*)(Bm + (size_t)row * 384 + c0) = o; }
    bf16* Bs = (bf16*)(a->ws + WS_S5BS) + (size_t)jg * 128 * 256;
    for (int pc = tid + half * 64 * 32; pc < (half + 1) * 64 * 32; pc += 512) { const int row = pc >> 5, cp = pc & 31, c0 = cp * 8, s = c0 >> 4, hp0 = c0 & 15; float v[8];
        if (row < 128) { const int p = row & 63; const float ar = APr[(15 - s) * 64 + p], ai = APi[(15 - s) * 64 + p];
#pragma unroll
            for (int e = 0; e < 8; ++e) { const float br = BBr[p * 16 + hp0 + e], bi = BBi[p * 16 + hp0 + e]; v[e] = (row < 64) ? (ar * br - ai * bi) : (ar * bi + ai * br); }
        } else {
#pragma unroll
            for (int e = 0; e < 8; ++e) v[e] = 0.f; }
        v4u o; o.x = pk2(v[0], v[1]); o.y = pk2(v[2], v[3]); o.z = pk2(v[4], v[5]); o.w = pk2(v[6], v[7]);
        *(GAS v4u*)(Bs + (size_t)row * 256 + c0) = o; }
    LDS_WAIT(); __syncthreads();
}

__device__ __forceinline__ void bf8_to_f32(const v4u w, float (&o)[8]) {
#pragma unroll
    for (int e = 0; e < 4; ++e) { o[2 * e] = __uint_as_float(w[e] << 16); o[2 * e + 1] = __uint_as_float(w[e] & 0xffff0000u); } }
__device__ __forceinline__ v4u f32_to_bf8(const float (&x)[8]) { v4u o; o.x = pk2(x[0], x[1]); o.y = pk2(x[2], x[3]); o.z = pk2(x[4], x[5]); o.w = pk2(x[6], x[7]); return o; }
__device__ __forceinline__ void norm_pass(Frame& F, const float* hsrc32, bf16* H16, const bf16* mix, const float* gpost, int premode, const float* gpre, bf16* AS5, float* out32, float* rowinv, bool wr_h, const bf16* wf = nullptr, const float* bfv = nullptr, float* LF = nullptr) {
    const int gw = F.vcu * NWAVES + F.wave, NGW = F.G * NWAVES; int lane_ = F.lane; asm volatile("" : "+v"(lane_)); const int lane = lane_;
    f32x4 gpo[2][2], gpr[2][2];
#pragma unroll
    for (int j = 0; j < 2; ++j) { const f32x4 z = {0.f, 0.f, 0.f, 0.f}; gpo[j][0] = z; gpo[j][1] = z; gpr[j][0] = z; gpr[j][1] = z;
        if (mix) { const GAS f32x4* gp = (const GAS f32x4*)(gpost + 8 * lane + 512 * j); gpo[j][0] = gp[0]; gpo[j][1] = gp[1]; }
        if (premode == 2) { const GAS f32x4* gp = (const GAS f32x4*)(gpre + 8 * lane + 512 * j); gpr[j][0] = gp[0]; gpr[j][1] = gp[1]; } }
    v4u wfr[16][2];
#pragma unroll
    for (int hh = 0; hh < 16; ++hh)
#pragma unroll
        for (int j = 0; j < 2; ++j) { const v4u z = {0u, 0u, 0u, 0u}; wfr[hh][j] = wf ? *(const GAS v4u*)(wf + (size_t)hh * D + 8 * lane + 512 * j) : z; }
    for (int m0 = gw; m0 < M; m0 += 2 * NGW) {
        float v[2][2][8]; v4u mw[2][2];
#pragma unroll
        for (int r = 0; r < 2; ++r) { const int m = m0 + r * NGW;
            if (hsrc32) {
#pragma unroll
                for (int j = 0; j < 2; ++j) { const GAS f32x4* xr = (const GAS f32x4*)(hsrc32 + (size_t)m * D + 8 * lane + 512 * j); const f32x4 a = __builtin_nontemporal_load(xr), b = __builtin_nontemporal_load(xr + 1);
                    v[r][j][0] = a.x; v[r][j][1] = a.y; v[r][j][2] = a.z; v[r][j][3] = a.w; v[r][j][4] = b.x; v[r][j][5] = b.y; v[r][j][6] = b.z; v[r][j][7] = b.w; }
            } else {
#pragma unroll
                for (int j = 0; j < 2; ++j) { const v4u w = *(const GAS v4u*)(H16 + (size_t)m * D + 8 * lane + 512 * j); bf8_to_f32(w, v[r][j]); } }
            if (mix) {
#pragma unroll
                for (int j = 0; j < 2; ++j) mw[r][j] = __builtin_nontemporal_load((const GAS v4u*)(mix + (size_t)m * D + 8 * lane + 512 * j)); } }
#pragma unroll
        for (int r = 0; r < 2; ++r) { const int m = m0 + r * NGW;
            if (mix) {
                float x[2][8]; float s = 0.f;
#pragma unroll
                for (int j = 0; j < 2; ++j) { bf8_to_f32(mw[r][j], x[j]);
#pragma unroll
                    for (int e = 0; e < 8; ++e) s += x[j][e] * x[j][e]; }
                const float rr = 1.f / sqrtf(wave_sum(s) * (1.f / D) + RMS_EPS);
#pragma unroll
                for (int j = 0; j < 2; ++j) { const f32x4 ga = gpo[j][0], gb = gpo[j][1];
                    v[r][j][0] += x[j][0] * rr * ga.x; v[r][j][1] += x[j][1] * rr * ga.y; v[r][j][2] += x[j][2] * rr * ga.z; v[r][j][3] += x[j][3] * rr * ga.w;
                    v[r][j][4] += x[j][4] * rr * gb.x; v[r][j][5] += x[j][5] * rr * gb.y; v[r][j][6] += x[j][6] * rr * gb.z; v[r][j][7] += x[j][7] * rr * gb.w; }
            }
            if (premode == 0) {
#pragma unroll
                for (int j = 0; j < 2; ++j) { GAS f32x4* orow = (GAS f32x4*)(out32 + (size_t)m * D + 8 * lane + 512 * j);
                    orow[0] = (f32x4){v[r][j][0], v[r][j][1], v[r][j][2], v[r][j][3]}; orow[1] = (f32x4){v[r][j][4], v[r][j][5], v[r][j][6], v[r][j][7]}; }
            } else {
                v4u hpk[2];
#pragma unroll
                for (int j = 0; j < 2; ++j) hpk[j] = f32_to_bf8(v[r][j]);
                if (wr_h) {
#pragma unroll
                    for (int j = 0; j < 2; ++j) *(GAS v4u*)(H16 + (size_t)m * D + 8 * lane + 512 * j) = hpk[j]; }
                float s2 = 0.f;
#pragma unroll
                for (int j = 0; j < 2; ++j)
#pragma unroll
                    for (int e = 0; e < 8; ++e) s2 += v[r][j][e] * v[r][j][e];
                const float inv = 1.f / sqrtf(wave_sum(s2) * (1.f / D) + RMS_EPS);
                if (premode == 1) { if (lane == 0) rowinv[m] = inv;
                    if (wf) {
                        typedef __bf16 bf16x2_t __attribute__((ext_vector_type(2)));
                        const unsigned hw[8] = {hpk[0].x, hpk[0].y, hpk[0].z, hpk[0].w, hpk[1].x, hpk[1].y, hpk[1].z, hpk[1].w};
                        float q8[8], q4[4], q2[2], q1;
                        { const bool up = (lane & 32) != 0;
#pragma unroll
                          for (int i = 0; i < 8; ++i) { float pa = 0.f, pb = 0.f;
                              const unsigned wa[8] = {wfr[i][0].x, wfr[i][0].y, wfr[i][0].z, wfr[i][0].w, wfr[i][1].x, wfr[i][1].y, wfr[i][1].z, wfr[i][1].w};
                              const unsigned wb[8] = {wfr[i + 8][0].x, wfr[i + 8][0].y, wfr[i + 8][0].z, wfr[i + 8][0].w, wfr[i + 8][1].x, wfr[i + 8][1].y, wfr[i + 8][1].z, wfr[i + 8][1].w};
#pragma unroll
                              for (int e = 0; e < 8; ++e) { pa = __builtin_amdgcn_fdot2_f32_bf16(__builtin_bit_cast(bf16x2_t, hw[e]), __builtin_bit_cast(bf16x2_t, wa[e]), pa, false);
                                                            pb = __builtin_amdgcn_fdot2_f32_bf16(__builtin_bit_cast(bf16x2_t, hw[e]), __builtin_bit_cast(bf16x2_t, wb[e]), pb, false); }
                              const float keep = up ? pb : pa, send = up ? pa : pb; q8[i] = keep + __shfl_xor(send, 32); } }
                        { const bool up = (lane & 16) != 0;
#pragma unroll
                          for (int i = 0; i < 4; ++i) { const float keep = up ? q8[i + 4] : q8[i], send = up ? q8[i] : q8[i + 4]; q4[i] = keep + __shfl_xor(send, 16); } }
                        { const bool up = (lane & 8) != 0;
#pragma unroll
                          for (int i = 0; i < 2; ++i) { const float keep = up ? q4[i + 2] : q4[i], send = up ? q4[i] : q4[i + 2]; q2[i] = keep + __shfl_xor(send, 8); } }
                        { const bool up = (lane & 4) != 0; const float keep = up ? q2[1] : q2[0], send = up ? q2[0] : q2[1]; q1 = keep + __shfl_xor(send, 4); }
                        q1 += __shfl_xor(q1, 2); q1 += __shfl_xor(q1, 1);
                        if ((lane & 3) == 0) { const int hh = lane >> 2; const float x = q1 * inv + bfv[hh]; LF[(size_t)m * 16 + hh] = fminf(x, 0.f) - __logf(1.0f + __expf(-fabsf(x))); }
                    } }
                else {
                    const int sc = m >> 4, t = m & 15;
#pragma unroll
                    for (int j = 0; j < 2; ++j) { const f32x4 ga = gpr[j][0], gb = gpr[j][1]; float w[8];
                        w[0] = v[r][j][0] * inv * ga.x; w[1] = v[r][j][1] * inv * ga.y; w[2] = v[r][j][2] * inv * ga.z; w[3] = v[r][j][3] * inv * ga.w;
                        w[4] = v[r][j][4] * inv * gb.x; w[5] = v[r][j][5] * inv * gb.y; w[6] = v[r][j][6] * inv * gb.z; w[7] = v[r][j][7] * inv * gb.w;
                        const int g = (lane >> 1) + 32 * j;
                        *(GAS v4u*)(AS5 + ((size_t)g * NSC + sc) * S5KA + t * 16 + 8 * (lane & 1)) = f32_to_bf8(w); }
                }
            }
        }
    }
}

__device__ __forceinline__ void s5_carry(Frame& F, int j) { const KArgsP a = KA;
    if (F.wave < 2) {
        int p_ = F.lane; asm volatile("" : "+v"(p_)); const int item = F.wave * 256 + (int)blockIdx.x; const int g = item >> 3, b = item & 7, p = p_; const int jg = j * 64 + g;
        const float dt = __expf(a->in[4][jg]); const float are = a->in[2][jg * 64 + p], aim = a->in[3][jg * 64 + p];
        const float mag = __expf(are * dt * 16.f), rev = aim * dt * 16.f * INV_2PI; const float ar = mag * cos_rev(rev), ai = mag * sin_rev(rev);
        const float* SL = (const float*)(a->ws + WS_SL) + ((size_t)g * NSC + b * 256) * 128;
        bf16* AS = (bf16*)(a->ws + WS_AS5) + ((size_t)g * NSC + b * 256) * S5KA + 256;
        float xr = 0.f, xi = 0.f;
#pragma unroll 16
        for (int sc = 0; sc < 256; ++sc) {
            const float lr = SL[(size_t)sc * 128 + p], li = SL[(size_t)sc * 128 + 64 + p];
            AS[(size_t)sc * S5KA + p] = (bf16)f2bf(xr); AS[(size_t)sc * S5KA + 64 + p] = (bf16)f2bf(xi);
            const float nr = ar * xr - ai * xi + lr, ni = ar * xi + ai * xr + li; xr = nr; xi = ni;
        }
    }
}

__device__ __forceinline__ void fox_cumsum(Frame& F, int j) { const KArgsP a = KA;
    if (blockIdx.x < NB * H) {
        int tid_ = F.tid; asm volatile("" : "+v"(tid_)); const int bh = blockIdx.x, b = bh >> 4, h = bh & 15, tid = tid_; const int lane_ = tid & 63;
        const float* LF = (const float*)(a->ws + WS_LF_OF(j)) + ((size_t)b * T + 8 * tid) * 16 + h;
        float v[8]; float run = 0.f;
#pragma unroll
        for (int i = 0; i < 8; ++i) { run += LF[i * 16]; v[i] = run; }
        float x = run;
#pragma unroll
        for (int o = 1; o < 64; o <<= 1) { const float tt = __shfl_up(x, o); if (lane_ >= o) x += tt; }
        LAS float* wt = (LAS float*)(F.lds + RING_OFF);
        if (lane_ == 63) wt[F.wave] = x;
        LDS_WAIT(); __syncthreads();
        float pre = x - run;
        for (int w = 0; w < F.wave; ++w) pre += wt[w];
        float* o = (float*)(a->ws + WS_CK2) + (size_t)bh * T + 8 * tid;
        const float L2E = 1.4426950408889634f;
        *(f32x4*)o = (f32x4){(pre + v[0]) * L2E, (pre + v[1]) * L2E, (pre + v[2]) * L2E, (pre + v[3]) * L2E};
        *(f32x4*)(o + 4) = (f32x4){(pre + v[4]) * L2E, (pre + v[5]) * L2E, (pre + v[6]) * L2E, (pre + v[7]) * L2E};
        LDS_WAIT(); __syncthreads();
    }
}

__device__ __forceinline__ void fox_norms(Frame& F, int j) {
    const KArgsP a = KA; int lane_ = F.lane; asm volatile("" : "+v"(lane_)); const int lane = lane_;
    const int gw = F.vcu * NWAVES + F.wave, NGW = F.G * NWAVES;
    for (int task = gw; task < M / 16; task += NGW) {
        const int m0 = task * 16; float qmx = 0.f, kmx = 0.f, dmx = 0.f;
#pragma unroll 4
        for (int r = 0; r < 16; ++r) {
            const v4u* qp = (const v4u*)((const bf16*)(a->ws + WS_Q) + (size_t)(m0 + r) * D + 16 * lane); const v4u* kp = (const v4u*)((const bf16*)(a->ws + WS_K) + (size_t)(m0 + r) * D + 16 * lane);
            const v4u q0 = qp[0], q1 = qp[1], k0 = kp[0], k1 = kp[1]; float sq = 0.f, sk = 0.f, sd = 0.f;
#pragma unroll
            for (int e = 0; e < 4; ++e) { float x;
                float y;
                x = __uint_as_float(q0[e] << 16); y = __uint_as_float(k0[e] << 16); sq += x * x; sk += y * y; sd += x * y;
                x = __uint_as_float(q0[e] & 0xffff0000u); y = __uint_as_float(k0[e] & 0xffff0000u); sq += x * x; sk += y * y; sd += x * y;
                x = __uint_as_float(q1[e] << 16); y = __uint_as_float(k1[e] << 16); sq += x * x; sk += y * y; sd += x * y;
                x = __uint_as_float(q1[e] & 0xffff0000u); y = __uint_as_float(k1[e] & 0xffff0000u); sq += x * x; sk += y * y; sd += x * y; }
            sq += __shfl_xor(sq, 1); sq += __shfl_xor(sq, 2); sk += __shfl_xor(sk, 1); sk += __shfl_xor(sk, 2); sd += __shfl_xor(sd, 1); sd += __shfl_xor(sd, 2);
            qmx = fmaxf(qmx, sq); kmx = fmaxf(kmx, sk); dmx = fmaxf(dmx, -sd);
        }
        if ((lane & 3) == 0) { const int b = m0 >> 12, qb = (m0 & 4095) >> 8, bh = b * 16 + (lane >> 2);
            __hip_atomic_fetch_max((unsigned*)(F.ctl + CW_QN2) + j * 2048 + bh * 16 + qb, __float_as_uint(qmx * 1.02f), RLX_AGENT);
            __hip_atomic_fetch_max((unsigned*)(F.ctl + CW_KN2) + j * 128 + bh, __float_as_uint(kmx * 1.02f), RLX_AGENT);
            __hip_atomic_fetch_max((unsigned*)(F.ctl + CW_DG2) + j * 2048 + bh * 16 + qb, __float_as_uint(dmx * 1.01f + 0.05f), RLX_AGENT); }
    }
}

__device__ __forceinline__ void p0_prologue(Frame& F, bool do_w, bool do_n) {
    if (do_w) s5_prep(F, ((int)blockIdx.x >> 6) & 1, (int)blockIdx.x & 63, (int)blockIdx.x >> 7);
    const KArgsP a = KA;
    const float* gains = a->in[1];
    if (do_w) {
    LAS float* scr = (LAS float*)(F.lds + RING_OFF + F.wave * 16384);
    const int gw = F.vcu * NWAVES + F.wave, NGW = F.G * NWAVES;
    constexpr int I_GLU = 16 * 64, I_WIN = 16 * 128, I_WOUT = 16 * 32, I_W1 = 16 * 128, I_W2 = 64 * 32, I_Z = 16;
    constexpr int NITEMS = 2 * I_GLU + 2 * I_WIN + 2 * I_WOUT + 4 * I_W1 + 4 * I_W2 + 2 * I_Z;
    for (int it = gw; it < NITEMS; it += NGW) {
        int r = it;
        if (r < 2 * I_GLU) { const int j = r / I_GLU; r -= j * I_GLU; const int kb = r >> 6, nb = r & 63, n0 = nb * 32;
            const int dst = (n0 < 1024) ? ((n0 >> 7) * 256 + (n0 & 127)) : ((((n0 - 1024) >> 7) * 256) + 128 + ((n0 - 1024) & 127));
            p0_transpose_item(a->in[10] + (size_t)j * 1024 * 2048, 1024, 2048, (bf16*)(a->ws + WS_WGLU) + (size_t)j * 2048 * 1024, kb * 64, n0, dst, nullptr, scr, F.lane); continue; }
        r -= 2 * I_GLU;
        if (r < 2 * I_WIN) { const int j = r / I_WIN; r -= j * I_WIN; const int kb = r >> 7, nb = r & 127, n0 = nb * 32;
            p0_transpose_item(a->in[11] + (size_t)j * 1024 * NPROJ_REAL, 1024, NPROJ_REAL, (bf16*)(a->ws + WS_WIN) + (size_t)j * NPROJ * 1024, kb * 64, n0, n0, gains + (size_t)(2 * j + 1) * 4 * D, scr, F.lane); continue; }
        r -= 2 * I_WIN;
        if (r < 2 * I_WOUT) { const int j = r / I_WOUT; r -= j * I_WOUT; const int kb = r >> 5, nb = r & 31, n0 = nb * 32;
            p0_transpose_item(a->in[13] + (size_t)j * 1024 * 1024, 1024, 1024, (bf16*)(a->ws + WS_WOUT) + (size_t)j * 1024 * 1024, kb * 64, n0, n0, nullptr, scr, F.lane); continue; }
        r -= 2 * I_WOUT;
        if (r < 4 * I_W1) { const int i = r / I_W1; r -= i * I_W1; const int kb = r >> 7, nb = r & 127, n0 = nb * 32;
            p0_transpose_item(a->in[14] + (size_t)i * 1024 * 4096, 1024, 4096, (bf16*)(a->ws + WS_W1) + (size_t)i * 4096 * 1024, kb * 64, n0, n0, gains + (size_t)i * 4 * D + 2 * D, scr, F.lane); continue; }
        r -= 4 * I_W1;
        if (r < 4 * I_W2) { const int i = r / I_W2; r -= i * I_W2; const int kb = r >> 5, nb = r & 31, n0 = nb * 32;
            p0_transpose_item(a->in[15] + (size_t)i * 4096 * 1024, 4096, 1024, (bf16*)(a->ws + WS_W2) + (size_t)i * 1024 * 4096, kb * 64, n0, n0, nullptr, scr, F.lane); continue; }
        r -= 4 * I_W2;
        { const int j = r / I_Z, hh = r % I_Z;
            const GAS float* wsrc = (const GAS float*)(a->in[11] + (size_t)j * 1024 * NPROJ_REAL) + 4096 + hh; const GAS float* gsrc = (const GAS float*)(gains + (size_t)(2 * j + 1) * 4 * D);
            float w[16];
#pragma unroll
            for (int e = 0; e < 16; ++e) w[e] = wsrc[(size_t)(16 * F.lane + e) * NPROJ_REAL] * gsrc[16 * F.lane + e];
            GAS v4u* dst = (GAS v4u*)((bf16*)(F.ctl + CW_WF) + ((size_t)j * 16 + hh) * 1024 + 16 * F.lane);
            v4u o0, o1; o0.x = pk2(w[0], w[1]); o0.y = pk2(w[2], w[3]); o0.z = pk2(w[4], w[5]); o0.w = pk2(w[6], w[7]); o1.x = pk2(w[8], w[9]); o1.y = pk2(w[10], w[11]); o1.z = pk2(w[12], w[13]); o1.w = pk2(w[14], w[15]);
            dst[0] = o0; dst[1] = o1; }
    }
    }
    if (do_n) norm_pass(F, a->in[0], nullptr, nullptr, nullptr, 2, gains, (bf16*)(a->ws + WS_AS5), nullptr, nullptr, false);
}

__global__ void __launch_bounds__(NWAVES * 64, 2) mk_fwd(Args args_unused) {
    extern __shared__ __attribute__((aligned(16))) unsigned char lds[];
    Frame F;
    F.lds = (LAS unsigned char*)lds;
    F.MISC = (volatile LAS unsigned*)(F.lds + MISC_OFF);
    F.tid = threadIdx.x; F.lane = F.tid & 63; F.wave = __builtin_amdgcn_readfirstlane(F.tid >> 6);
    F.G = gridDim.x; { const int bx = blockIdx.x; F.vcu = (F.G % 8 == 0) ? (bx % 8) * (F.G / 8) + bx / 8 : bx; }
    F.ctl = (gu32*)(KA->ws + WS_CTL);
    for (int u = F.tid; u < (LDS_BYTES - LDSCTL_OFF) / 4; u += NWAVES * 64) ((LAS unsigned*)(F.lds + LDSCTL_OFF))[u] = 0u;
    __syncthreads();
    XcdBarrier bar = xcd_barrier_post((unsigned*)(F.ctl + CW_BAR), F.MISC + 8);
#define GRID_BAR() do { XcdBarrier b_ = bar; asm volatile("" : "+s"(b_.bar), "+s"(b_.x)); xcd_barrier(b_); } while (0)
#define WSP(T_, off) ((T_*)(KA->ws + (off)))
#define GAINS(i_, k_) (KA->in[1] + (size_t)(i_) * 4 * D + (size_t)(k_) * D)

#ifndef SKIP_PRO
    p0_prologue(F, true, true);
#ifdef PROBE_PRO_W
    GRID_BAR(); p0_prologue(F, true, false);
#endif
#ifdef PROBE_PRO_N
    GRID_BAR(); p0_prologue(F, false, true);
#endif
#endif
    if (F.G != 256) cooperative_groups::this_grid().sync();
    GRID_BAR();
#ifdef PROBE_BAR
    for (int pb = 0; pb < 20; ++pb) GRID_BAR();
#endif
#ifdef PROBE_CGSYNC
    for (int pb = 0; pb < 20; ++pb) cooperative_groups::this_grid().sync();
#endif
#if NSUB == 0
    norm_pass(F, KA->in[0], nullptr, nullptr, nullptr, 0, nullptr, nullptr, KA->out, nullptr, false);
#else
    for (int i = 0; i < DEPTH; ++i) {
        if (2 * i >= NSUB) break;
        const int j = i >> 1;
        if ((i & 1) == 0) {
#ifndef SKIP_S5LOC
            for (int k = 0; k < 2; ++k) {
              pg8::Gemm g{WSP(const bf16, WS_AS5), WSP(const bf16, WS_S5BS) + (size_t)j * 64 * 128 * 256, 64 * NSC, 256, 256, S5KA, 256, 128}; const pg8::S5OneOrder S{256 * k + F.vcu};
              pg8::EpiS5LocCarry E{WSP(bf16, WS_AS5), KA->in[2] + (size_t)j * 4096, KA->in[3] + (size_t)j * 4096, KA->in[4] + (size_t)j * 64};
              pg8::gemm_phase<pg8::EpiS5LocCarry, pg8::S5OneOrder, false, true>(F.lds + RING_OFF, g, S, E); }
#endif
            asm volatile("s_waitcnt vmcnt(0)" ::: "memory"); __syncthreads();
#ifndef SKIP_S5MAIN
            { pg8::Gemm g{WSP(const bf16, WS_AS5), WSP(const bf16, WS_S5BM) + (size_t)j * 64 * 256 * 384, 64 * NSC, 256, 384, S5KA, 384, 256}; pg8::S5Order S; S.init(F.G, F.vcu);
              pg8::EpiS5Main E{WSP(bf16, WS_G), WSP(const bf16, WS_AS5), KA->in[9] + (size_t)j * D};
              pg8::gemm_phase<pg8::EpiS5Main, pg8::S5Order, true, true>(F.lds + RING_OFF, g, S, E); }
#ifdef PROBE_S5MAIN
            GRID_BAR();
            { pg8::Gemm g{WSP(const bf16, WS_AS5), WSP(const bf16, WS_S5BM) + (size_t)j * 64 * 256 * 384, 64 * NSC, 256, 384, S5KA, 384, 256}; pg8::S5Order S; S.init(F.G, F.vcu);
              pg8::EpiS5Main E{WSP(bf16, WS_G), WSP(const bf16, WS_AS5), KA->in[9] + (size_t)j * D};
              pg8::gemm_phase<pg8::EpiS5Main, pg8::S5Order, true, true>(F.lds + RING_OFF, g, S, E); }
#endif
#endif
            GRID_BAR();
#ifndef SKIP_GLU
            { pg8::Gemm g{WSP(const bf16, WS_G), WSP(const bf16, WS_WGLU) + (size_t)j * 2048 * 1024, M, 2048, D, D, D, 256}; pg8::StaticOrder S; S.init(M, 2048, F.G, (int)blockIdx.x, WGM_GLU);
              pg8::EpiGLU E{WSP(bf16, WS_XN), D};
              pg8::gemm_phase<pg8::EpiGLU, pg8::StaticOrder, true, true>(F.lds + RING_OFF, g, S, E); }
#ifdef PROBE_GLU
            GRID_BAR();
            { pg8::Gemm g{WSP(const bf16, WS_G), WSP(const bf16, WS_WGLU) + (size_t)j * 2048 * 1024, M, 2048, D, D, D, 256}; pg8::StaticOrder S; S.init(M, 2048, F.G, (int)blockIdx.x, WGM_GLU);
              pg8::EpiGLU E{WSP(bf16, WS_XN), D};
              pg8::gemm_phase<pg8::EpiGLU, pg8::StaticOrder, true, true>(F.lds + RING_OFF, g, S, E); }
#endif
#endif
        } else {
#ifndef SKIP_PROJ
            { pg8::Gemm g{WSP(const bf16, WS_H16), WSP(const bf16, WS_WIN) + (size_t)j * NPROJ * 1024, M, NPROJ, D, D, D, 256}; pg8::StaticOrder S; S.init(M, NPROJ, F.G, (int)blockIdx.x, WGM_PROJ);
              pg8::EpiProj E{WSP(bf16, WS_Q), (size_t)M * D, attn_body::C2, (const float*)(F.ctl + CW_ROWINV)};
              pg8::gemm_phase<pg8::EpiProj, pg8::StaticOrder, true, true>(F.lds + RING_OFF, g, S, E); }
#ifdef PROBE_PROJ
            GRID_BAR();
            { pg8::Gemm g{WSP(const bf16, WS_H16), WSP(const bf16, WS_WIN) + (size_t)j * NPROJ * 1024, M, NPROJ, D, D, D, 256}; pg8::StaticOrder S; S.init(M, NPROJ, F.G, (int)blockIdx.x, WGM_PROJ);
              pg8::EpiProj E{WSP(bf16, WS_Q), (size_t)M * D, attn_body::C2, (const float*)(F.ctl + CW_ROWINV)};
              pg8::gemm_phase<pg8::EpiProj, pg8::StaticOrder, true, true>(F.lds + RING_OFF, g, S, E); }
#endif
#endif
            GRID_BAR();
#ifndef SKIP_CUMSUM
            fox_cumsum(F, j);
            fox_norms(F, j);
#endif
            GRID_BAR();
#ifndef SKIP_ATTN
            { const attn_body::AttnTensors AT{WSP(const attn_body::bf16, WS_Q), WSP(const attn_body::bf16, WS_K), WSP(const attn_body::bf16, WS_V), WSP(const attn_body::bf16, WS_GATE), WSP(const float, WS_CK2), (const unsigned*)(F.ctl + CW_QN2) + j * 2048, (const unsigned*)(F.ctl + CW_KN2) + j * 128, (const unsigned*)(F.ctl + CW_DG2) + j * 2048, WSP(attn_body::bf16, WS_Q)};
              const attn_body::QueueOrder S{(unsigned*)(F.ctl + CW_QCTR) + 64 * j, F.MISC + 16};
              attn_body::attn_phase<attn_body::QueueOrder>((char*)lds + RING_OFF, AT, S); }
#endif
            GRID_BAR();
#ifndef SKIP_WO
            { pg8::Gemm g{WSP(const bf16, WS_Q), WSP(const bf16, WS_WOUT) + (size_t)j * 1024 * 1024, M, D, D, D, D, 256}; pg8::StaticOrder S; S.init(M, D, F.G, (int)blockIdx.x, WGM_WO);
              pg8::EpiPlain E{WSP(bf16, WS_XN), D};
              pg8::gemm_phase<pg8::EpiPlain, pg8::StaticOrder, true, true>(F.lds + RING_OFF, g, S, E); }
#ifdef PROBE_WO
            GRID_BAR();
            { pg8::Gemm g{WSP(const bf16, WS_Q), WSP(const bf16, WS_WOUT) + (size_t)j * 1024 * 1024, M, D, D, D, D, 256}; pg8::StaticOrder S; S.init(M, D, F.G, (int)blockIdx.x, WGM_WO);
              pg8::EpiPlain E{WSP(bf16, WS_XN), D};
              pg8::gemm_phase<pg8::EpiPlain, pg8::StaticOrder, true, true>(F.lds + RING_OFF, g, S, E); }
#endif
#endif
        }
        GRID_BAR();
        const bool lastsub = (2 * i + 1 >= NSUB);
        norm_pass(F, i == 0 ? KA->in[0] : (const float*)nullptr, WSP(bf16, WS_H16), WSP(const bf16, WS_XN), GAINS(i, 1), lastsub ? 0 : 1, nullptr, nullptr, KA->out, (float*)(F.ctl + CW_ROWINV), true);
        if (lastsub) break;
        GRID_BAR();
#ifndef SKIP_MLP
        { pg8::Gemm g{WSP(const bf16, WS_H16), WSP(const bf16, WS_W1) + (size_t)i * 4096 * 1024, M, FF, D, D, D, 256}; pg8::StaticOrder S; S.init(M, FF, F.G, (int)blockIdx.x, WGM_MLP1);
          pg8::EpiRelu2 E{WSP(bf16, WS_BIG), FF, (const float*)(F.ctl + CW_ROWINV)};
          pg8::gemm_phase<pg8::EpiRelu2, pg8::StaticOrder, true, true>(F.lds + RING_OFF, g, S, E); }
#ifdef PROBE_MLP1
            GRID_BAR();
        { pg8::Gemm g{WSP(const bf16, WS_H16), WSP(const bf16, WS_W1) + (size_t)i * 4096 * 1024, M, FF, D, D, D, 256}; pg8::StaticOrder S; S.init(M, FF, F.G, (int)blockIdx.x, WGM_MLP1);
          pg8::EpiRelu2 E{WSP(bf16, WS_BIG), FF, (const float*)(F.ctl + CW_ROWINV)};
          pg8::gemm_phase<pg8::EpiRelu2, pg8::StaticOrder, true, true>(F.lds + RING_OFF, g, S, E); }
#endif
        GRID_BAR();
        { pg8::Gemm g{WSP(const bf16, WS_BIG), WSP(const bf16, WS_W2) + (size_t)i * 1024 * 4096, M, D, FF, FF, FF, 256}; pg8::StaticOrder S; S.init(M, D, F.G, (int)blockIdx.x, WGM_MLP2);
          pg8::EpiPlain E{WSP(bf16, WS_XN), D};
          pg8::gemm_phase<pg8::EpiPlain, pg8::StaticOrder, true, true>(F.lds + RING_OFF, g, S, E); }
#ifdef PROBE_MLP2
            GRID_BAR();
        { pg8::Gemm g{WSP(const bf16, WS_BIG), WSP(const bf16, WS_W2) + (size_t)i * 1024 * 4096, M, D, FF, FF, FF, 256}; pg8::StaticOrder S; S.init(M, D, F.G, (int)blockIdx.x, WGM_MLP2);
          pg8::EpiPlain E{WSP(bf16, WS_XN), D};
          pg8::gemm_phase<pg8::EpiPlain, pg8::StaticOrder, true, true>(F.lds + RING_OFF, g, S, E); }
#endif
#endif
        GRID_BAR();
        const bool fin = (2 * i + 2 >= NSUB) || (i == DEPTH - 1);
        const int premode = fin ? 0 : (((i + 1) & 1) == 0 ? 2 : 1);
        if (premode == 1)
            norm_pass(F, nullptr, WSP(bf16, WS_H16), WSP(const bf16, WS_XN), GAINS(i, 3), 1, nullptr, nullptr, nullptr, (float*)(F.ctl + CW_ROWINV), true,
                      (const bf16*)(F.ctl + CW_WF) + (size_t)(i >> 1) * 16 * 1024, KA->in[12] + (size_t)(i >> 1) * H, WSP(float, WS_LF_OF(i >> 1)));
        else
            norm_pass(F, nullptr, WSP(bf16, WS_H16), WSP(const bf16, WS_XN), GAINS(i, 3), premode, GAINS(i + 1 < DEPTH ? i + 1 : i, 0), WSP(bf16, WS_AS5), KA->out, (float*)(F.ctl + CW_ROWINV), true);
        if (fin) break;
        GRID_BAR();
    }
#endif
}

extern "C" void kernel_launch(void* const* d_in, const int* in_sizes, int n_in, void* d_out, int out_size, void* d_ws, size_t ws_size, hipStream_t stream) {
    static int grid = 0;
    if (grid == 0) {
        if (n_in != 16 || in_sizes[0] != M * D || out_size != M * D || ws_size < WS_END) { fprintf(stderr, "kernel_launch: unexpected shapes (n_in %d, in0 %d, out %d, ws %zu); nothing launched\n", n_in, n_in > 0 ? in_sizes[0] : -1, out_size, ws_size); grid = -1; return; }
        int dev = 0, cus = 0, per_cu = 0;
        if (hipGetDevice(&dev) != hipSuccess || hipDeviceGetAttribute(&cus, hipDeviceAttributeMultiprocessorCount, dev) != hipSuccess) { grid = -1; return; }
        if (hipFuncSetAttribute((const void*)mk_fwd, hipFuncAttributeMaxDynamicSharedMemorySize, LDS_BYTES) != hipSuccess) { fprintf(stderr, "kernel_launch: hipFuncSetAttribute failed\n"); grid = -1; return; }
        if (hipOccupancyMaxActiveBlocksPerMultiprocessor(&per_cu, (const void*)mk_fwd, NWAVES * 64, LDS_BYTES) != hipSuccess || per_cu < 1) { fprintf(stderr, "kernel_launch: occupancy query says %d\n", per_cu); per_cu = 1; }
        (void)hipGetLastError();
        grid = cus;
    }
    if (grid < 0) return;
    if (hipMemsetAsync((char*)d_ws + WS_CTL, 0, CTL_ZERO_BYTES, stream) != hipSuccess) { fprintf(stderr, "kernel_launch: hipMemsetAsync failed\n"); return; }
    Args a{};
    for (int i = 0; i < 16; ++i) a.in[i] = (const float*)d_in[i];
    a.out = (float*)d_out; a.ws = (unsigned char*)d_ws;
    void* kargv[] = {&a};
    const hipError_t le = hipLaunchCooperativeKernel((const void*)mk_fwd, dim3(grid), dim3(NWAVES * 64), kargv, LDS_BYTES, stream);
    if (le != hipSuccess) fprintf(stderr, "kernel_launch: cooperative launch failed: %s (grid %d)\n", hipGetErrorName(le), grid);
}
```
